# Optimizing an MI355X kernel written in HIP

```python
import jax, jax.numpy as jnp
from jax import lax
import numpy as np

D_MODEL = 1024
BATCH = 8
SEQ = 2048
DEPTH = 2
DEC_BATCH = 128
DEC_SEQ = 1
PAST_LEN = 16384
PAGE_SIZE = 128

MIX = 2 * D_MODEL
RET_HEADS = 8
RET_WIDTH = MIX // 2
RET_DK = RET_WIDTH // RET_HEADS
RET_DV = RET_WIDTH // RET_HEADS
GM_HEADS = 8
GM_WIDTH = MIX - RET_WIDTH
GM_DIM = GM_WIDTH // GM_HEADS
CHUNK = 128
ROPE_BASE = 10000.0
EPS = 1e-6
SPLITS = [RET_WIDTH, 2 * RET_WIDTH, 3 * RET_WIDTH, 4 * RET_WIDTH,
          4 * RET_WIDTH + GM_WIDTH, 4 * RET_WIDTH + 2 * GM_WIDTH]
IN_COLS = 4 * RET_WIDTH + 3 * GM_WIDTH

kernel_name = "hybrid_retention_gmlp_decoder_step"


def _rmsnorm(x, g):
    xf = x.astype(jnp.float32)
    y = xf * lax.rsqrt(jnp.mean(xf * xf, axis=-1, keepdims=True) + EPS) * g.astype(jnp.float32)
    return y.astype(x.dtype)


def _layernorm(x, g, b):
    xf = x.astype(jnp.float32)
    mu = jnp.mean(xf, axis=-1, keepdims=True)
    var = jnp.mean(jnp.square(xf - mu), axis=-1, keepdims=True)
    y = (xf - mu) * lax.rsqrt(var + EPS) * g.astype(jnp.float32) + b.astype(jnp.float32)
    return y.astype(x.dtype)


def _rope(x, pos):
    d = x.shape[-1]
    inv = ROPE_BASE ** (-jnp.arange(0, d, 2, dtype=jnp.float32) / d)
    ang = pos[:, None] * inv[None, :]
    c = jnp.cos(ang)[:, None, :]
    s = jnp.sin(ang)[:, None, :]
    xf = x.astype(jnp.float32)
    x1, x2 = xf[..., : d // 2], xf[..., d // 2:]
    return jnp.concatenate([x1 * c - x2 * s, x1 * s + x2 * c], axis=-1)


def _log_gamma():
    return jnp.log(1.0 - 2.0 ** (-5.0 - jnp.arange(RET_HEADS, dtype=jnp.float32)))


def _retention(q, k, v, S0):
    B, T, H, _ = q.shape
    c = CHUNK if T % CHUNK == 0 else T
    n = T // c
    lg = _log_gamma()
    idx = jnp.arange(c, dtype=jnp.float32)
    diff = idx[:, None] - idx[None, :]
    decay = jnp.where(diff >= 0, jnp.exp(lg[:, None, None] * jnp.maximum(diff, 0.0)), 0.0)
    q_dec = jnp.exp(lg[None, :] * (idx[:, None] + 1.0))
    k_dec = jnp.exp(lg[None, :] * (c - 1.0 - idx[:, None]))
    s_dec = jnp.exp(lg * c)

    def to_chunks(a):
        return a.astype(jnp.float32).reshape(B, n, c, H, -1).transpose(1, 0, 2, 3, 4)

    def body(S, blk):
        qc, kc, vc = blk
        sc = jnp.einsum('bihd,bjhd->bhij', qc, kc) * decay
        o = (jnp.einsum('bhij,bjhv->bihv', sc, vc)
             + jnp.einsum('bihd,bhdv->bihv', qc, S) * q_dec[None, :, :, None])
        S = S * s_dec[None, :, None, None] + jnp.einsum('bjhd,bjhv->bhdv', kc * k_dec[None, :, :, None], vc)
        return S, o

    S, o = lax.scan(body, S0.astype(jnp.float32), (to_chunks(q), to_chunks(k), to_chunks(v)))
    o = o.transpose(1, 0, 2, 3, 4).reshape(B, T, H, -1)
    return o, S


def _spatial_gate(v, ws, bs):
    B, T, GH, GD = v.shape
    c = CHUNK if T % CHUNK == 0 else T
    n = T // c
    w = jnp.tril(ws[:, :c, :c])
    b = bs[:, :c].T
    vc = v.reshape(B, n, c, GH, GD)
    s = jnp.einsum('hij,bnjhg->bnihg', w, vc) + b[None, None, :, :, None]
    return s.reshape(B, T, GH, GD)


def _layer(h, pos, S0, norm_g, w_in, w_out, ws, bs, ln_g, ln_b):
    B, T, _ = h.shape
    xn = _rmsnorm(h, norm_g)
    proj = jnp.einsum('btd,de->bte', xn, w_in)
    q, k, v, g_r, u, v_g, g_g = jnp.split(proj, SPLITS, axis=-1)
    q = _rope(q.reshape(B, T, RET_HEADS, RET_DK), pos)
    k = _rope(k.reshape(B, T, RET_HEADS, RET_DK), pos) * (RET_DK ** -0.5)
    v = v.reshape(B, T, RET_HEADS, RET_DV)
    o, S = _retention(q, k, v, S0)
    o = o * lax.rsqrt(jnp.mean(o * o, axis=-1, keepdims=True) + EPS)
    o = o.reshape(B, T, RET_WIDTH).astype(h.dtype) * jax.nn.silu(g_r)
    vn = _layernorm(v_g, ln_g, ln_b).reshape(B, T, GM_HEADS, GM_DIM)
    s = _spatial_gate(vn, ws, bs).reshape(B, T, GM_WIDTH)
    m = u * s.astype(h.dtype) * jax.nn.silu(g_g)
    y = jnp.einsum('bte,ed->btd', jnp.concatenate([o, m], axis=-1), w_out)
    return h + y, S.astype(S0.dtype), vn


def setup_inputs(seed: int = 0) -> dict:
    key = jax.random.key(seed)
    ks = jax.random.split(key, 12)
    f32 = jnp.float32
    return {
        "x_prompt": jax.random.normal(ks[0], (BATCH, SEQ, D_MODEL), f32),
        "x_sample": jax.random.normal(ks[1], (DEC_BATCH, DEC_SEQ, D_MODEL), f32),
        "state_ret": 0.5 * jax.random.normal(ks[2], (DEPTH, DEC_BATCH, RET_HEADS, RET_DK, RET_DV), f32),
        "norm_g": 1.0 + 0.02 * jax.random.normal(ks[3], (DEPTH, D_MODEL), f32),
        "w_in": jax.random.normal(ks[4], (DEPTH, D_MODEL, IN_COLS), f32) * D_MODEL ** -0.5,
        "w_out": jax.random.normal(ks[5], (DEPTH, MIX, D_MODEL), f32) * MIX ** -0.5,
        "gm_ws": jax.random.normal(ks[6], (DEPTH, GM_HEADS, CHUNK, CHUNK), f32) * CHUNK ** -0.5,
        "gm_b": 1.0 + 0.02 * jax.random.normal(ks[7], (DEPTH, GM_HEADS, CHUNK), f32),
        "gm_ln_g": 1.0 + 0.02 * jax.random.normal(ks[8], (DEPTH, GM_WIDTH), f32),
        "gm_ln_b": 0.02 * jax.random.normal(ks[9], (DEPTH, GM_WIDTH), f32),
        "final_g": 1.0 + 0.02 * jax.random.normal(ks[10], (D_MODEL,), f32),
    }


def reference(x_prompt, x_sample, state_ret, norm_g, w_in, w_out, gm_ws, gm_b, gm_ln_g, gm_ln_b, final_g):
    pos_p = jnp.arange(SEQ, dtype=jnp.float32)
    pos_s = PAST_LEN + jnp.arange(DEC_SEQ, dtype=jnp.float32)
    s0_prompt = jnp.zeros((BATCH, RET_HEADS, RET_DK, RET_DV), state_ret.dtype)
    h_p, h_s = x_prompt, x_sample
    sp_list, ss_list, vs_list = [], [], []
    for l in range(DEPTH):
        h_p, S_p, _ = _layer(h_p, pos_p, s0_prompt, norm_g[l], w_in[l], w_out[l],
                             gm_ws[l], gm_b[l], gm_ln_g[l], gm_ln_b[l])
        h_s, S_s, v_s = _layer(h_s, pos_s, state_ret[l], norm_g[l], w_in[l], w_out[l],
                               gm_ws[l], gm_b[l], gm_ln_g[l], gm_ln_b[l])
        sp_list.append(S_p)
        ss_list.append(S_s)
        vs_list.append(v_s)
    y_prompt = _rmsnorm(h_p, final_g)
    y_sample = _rmsnorm(h_s, final_g)
    state_ret_prompt = jnp.stack(sp_list)
    state_ret_sample = jnp.stack(ss_list)
    state_gm_v_sample = jnp.stack(vs_list)
    return (y_prompt, y_sample, state_ret_prompt, state_ret_sample, state_gm_v_sample)
```

```cpp
#include <hip/hip_runtime.h>
#include <cstdio>
#include <cstdint>

#ifndef MK_PER_PHASE
#define MK_PER_PHASE 0
#endif

namespace pg8 {
#define PG8_LAS __attribute__((address_space(3)))
typedef unsigned short bf16_t;
typedef short bf16x8 __attribute__((ext_vector_type(8)));
typedef float f32x4 __attribute__((ext_vector_type(4)));
typedef unsigned u32x4 __attribute__((ext_vector_type(4)));
typedef unsigned u32x2 __attribute__((ext_vector_type(2)));
constexpr int BM = 256, BK = 64, HALF = 128, HTB = HALF * BK * 2  , STAGE_BYTES = 8 * HTB, NXCD = 8, WGM = 8;

__host__ __device__ __forceinline__ int lds_byte(int r, int c) { const int st = (r >> 4) * 2 + (c >> 5), rr = r & 15, cc = c & 31, ob = rr * 64 + cc * 2; return st * 1024 + (ob ^ (((ob >> 9) & 1) << 5)); }
__host__ __device__ __forceinline__ void stage_rc(int b, int& R, int& C) { const int st = b / 1024, sb = b % 1024, swz = sb ^ (((sb >> 9) & 1) << 5); R = (st >> 1) * 16 + swz / 64; C = (st & 1) * 32 + (swz % 64) / 2; }
__host__ __device__ __forceinline__ int perm32(int rho) { const int n = rho >> 4, i = rho & 15; return 8 * (i >> 2) + 4 * n + (i & 3); }

struct Unit { int pm, pn; };
struct Gemm { const bf16_t* A; const bf16_t* Bt; int M, N, K; };

struct StaticOrder {
    int nM, nN, nwg, G, c;
    __host__ __device__ void init(int M, int N, int G_, int c_) { nM = M / BM; nN = N / BM; nwg = nM * nN; G = G_; c = c_; }
    __host__ __device__ bool next(int i, Unit& u) const {
        const long L = (long)i * G + c; if (L >= nwg) return false;
        int wgid = (int)L; { const int q = nwg / NXCD, r = nwg % NXCD, xcd = wgid % NXCD, off = wgid / NXCD; wgid = (xcd < r ? xcd * (q + 1) : r * (q + 1) + (xcd - r) * q) + off; }
        const int nig = WGM * nN, gid = wgid / nig, fm = gid * WGM, gsz = (nM - fm) < WGM ? (nM - fm) : WGM;
        u.pm = fm + ((wgid % nig) % gsz); u.pn = (wgid % nig) / gsz; return true;
    }
    __device__ __forceinline__ void a_ready(const Unit&) const {}
    __device__ __forceinline__ void done(const Unit&) const {}
};

__device__ __forceinline__ unsigned cvt_pk_bf16(float lo, float hi) { unsigned r; asm volatile("v_cvt_pk_bf16_f32 %0, %1, %2" : "=v"(r) : "v"(lo), "v"(hi)); return r; }

template <class Epi, class Sched, bool ALIGN_EPI = false, bool SP2 = false>
__device__ __forceinline__ void gemm_phase(PG8_LAS unsigned char* lds, const Gemm g, const Sched& S, const Epi& E) {
    int tid_ = threadIdx.x; asm volatile("" : "+v"(tid_));
    const int tid = tid_, wid = __builtin_amdgcn_readfirstlane(tid >> 6), lane = tid & 63, wr = wid >> 2, wc = wid & 3, fr = lane & 15, fq = lane >> 4;
    const int K = g.K, nt = K / BK;
    unsigned voffA[2], voffB[2];
#pragma unroll
    for (int i = 0; i < 2; ++i) { int R, C; stage_rc(tid * 16 + i * 8192, R, C); const int Rb = Epi::PERM ? ((R & ~31) + perm32(R & 31)) : R;
        voffA[i] = (unsigned)(R * K + C) * 2u; voffB[i] = (unsigned)(Rb * K + C) * 2u; }
    const size_t kstep = (size_t)(BK * 2);
    const size_t hstep = (size_t)HALF * K * 2;
    const size_t tstep = 2 * hstep;
    const unsigned ldsw = (unsigned)wid * 1024u;
    const int aoff = lds_byte(wr * 64 + fr, fq * 8), boff = lds_byte(wc * 32 + fr, fq * 8);
#define PG8_SA(b, h) (((b) * 2 + (h)) * HTB)
#define PG8_SB(b, h) ((4 + (b) * 2 + (h)) * HTB)
#define PG8_STAGE(bufoff, gbase, voff) do { _Pragma("unroll") for (int _i = 0; _i < 2; ++_i) \
        __builtin_amdgcn_global_load_lds((const unsigned*)((const char*)(gbase) + (voff)[_i]), (PG8_LAS unsigned*)(lds + (bufoff) + ldsw + _i * 8192), 16, 0, 0); } while (0)
#define PG8_LDA(dst, b, h) do { _Pragma("unroll") for (int m = 0; m < 4; ++m) _Pragma("unroll") for (int k = 0; k < 2; ++k) dst[m][k] = *(const PG8_LAS bf16x8*)(lds + PG8_SA(b, h) + aoff + m * 2048 + k * 1024); } while (0)
#define PG8_LDB(dst, b, h) do { _Pragma("unroll") for (int n = 0; n < 2; ++n) _Pragma("unroll") for (int k = 0; k < 2; ++k) dst[n][k] = *(const PG8_LAS bf16x8*)(lds + PG8_SB(b, h) + boff + n * 2048 + k * 1024); } while (0)
#define PG8_MMA(ai, bj, At, Bt) do { __builtin_amdgcn_s_setprio(1); _Pragma("unroll") for (int m = 0; m < 4; ++m) _Pragma("unroll") for (int n = 0; n < 2; ++n) _Pragma("unroll") for (int k = 0; k < 2; ++k) \
        acc[ai][bj][m][n] = __builtin_amdgcn_mfma_f32_16x16x32_bf16(Bt[n][k], At[m][k], acc[ai][bj][m][n], 0, 0, 0); __builtin_amdgcn_s_setprio(0); } while (0)
#define PG8_WAIT_V(n) asm volatile("s_waitcnt vmcnt(" #n ")" ::: "memory")
#define PG8_WAIT_L(n) asm volatile("s_waitcnt lgkmcnt(" #n ")" ::: "memory")
#define PG8_BAR __builtin_amdgcn_s_barrier()
#define PG8_SCHED __builtin_amdgcn_sched_barrier(0)
    Unit cur, nxt; int ui = 0;
    if (!S.next(0, cur)) return;
    f32x4 acc[2][2][4][2];
#pragma unroll
    for (int a = 0; a < 2; ++a)
#pragma unroll
        for (int b = 0; b < 2; ++b)
#pragma unroll
            for (int m = 0; m < 4; ++m)
#pragma unroll
                for (int n = 0; n < 2; ++n) acc[a][b][m][n] = (f32x4){0.f, 0.f, 0.f, 0.f};
    bf16x8 At[4][2], B0[2][2], B1[2][2];
    const char* cA = (const char*)g.A + (size_t)cur.pm * tstep; const char* cB = (const char*)g.Bt + (size_t)cur.pn * tstep;
    S.a_ready(cur);
    if constexpr (SP2) {
        PG8_STAGE(PG8_SB(0, 0), cB, voffB); PG8_STAGE(PG8_SB(0, 1), cB + hstep, voffB); PG8_STAGE(PG8_SA(0, 0), cA, voffA); PG8_STAGE(PG8_SA(0, 1), cA + hstep, voffA);
        if (wr == 1) PG8_BAR;
        PG8_WAIT_V(2); PG8_BAR;
        PG8_STAGE(PG8_SB(1, 0), cB + kstep, voffB); PG8_STAGE(PG8_SA(1, 0), cA + kstep, voffA); PG8_STAGE(PG8_SB(1, 1), cB + hstep + kstep, voffB);
        PG8_WAIT_V(6); PG8_BAR;
    } else {
        PG8_STAGE(PG8_SB(0, 0), cB, voffB); PG8_STAGE(PG8_SA(0, 0), cA, voffA); PG8_STAGE(PG8_SB(0, 1), cB + hstep, voffB); PG8_STAGE(PG8_SA(0, 1), cA + hstep, voffA);
        if (wr == 1) PG8_BAR;
        PG8_WAIT_V(4); PG8_BAR;
        PG8_STAGE(PG8_SB(1, 0), cB + kstep, voffB); PG8_STAGE(PG8_SA(1, 0), cA + kstep, voffA); PG8_STAGE(PG8_SB(1, 1), cB + hstep + kstep, voffB);
        PG8_WAIT_V(6); PG8_BAR;
    }
    for (;;) {
        const bool has_next = S.next(ui + 1, nxt);
        const char* nA = has_next ? (const char*)g.A + (size_t)nxt.pm * tstep : cA; const char* nB = has_next ? (const char*)g.Bt + (size_t)nxt.pn * tstep : cB;
        for (int t = 0; t < nt; t += 2) {
            const bool last = (t == nt - 2);
            const char* a1 = cA + (size_t)(t + 1) * kstep;
            const char* a2 = last ? nA : cA + (size_t)(t + 2) * kstep; const char* b2 = last ? nB : cB + (size_t)(t + 2) * kstep;
            const char* a3 = a2 + kstep; const char* b3 = b2 + kstep;
            if (last && has_next) S.a_ready(nxt);
            if constexpr (SP2) {
            PG8_LDB(B0, 0, 0); PG8_LDB(B1, 0, 1); PG8_SCHED; PG8_LDA(At, 0, 0); PG8_STAGE(PG8_SA(1, 1), a1 + hstep, voffA);
            PG8_WAIT_V(8); PG8_WAIT_L(0); PG8_BAR; PG8_MMA(0, 0, At, B0); PG8_MMA(0, 1, At, B1); PG8_BAR; PG8_SCHED;
            PG8_LDA(At, 0, 1); PG8_STAGE(PG8_SB(0, 0), b2, voffB); PG8_STAGE(PG8_SB(0, 1), b2 + hstep, voffB); PG8_STAGE(PG8_SA(0, 0), a2, voffA);
            PG8_WAIT_V(8); PG8_WAIT_L(0); PG8_BAR; PG8_MMA(1, 0, At, B0); PG8_MMA(1, 1, At, B1); PG8_BAR; PG8_SCHED;
            PG8_LDB(B0, 1, 0); PG8_LDB(B1, 1, 1); PG8_SCHED; PG8_LDA(At, 1, 0); PG8_STAGE(PG8_SA(0, 1), a2 + hstep, voffA);
            PG8_WAIT_V(8); PG8_WAIT_L(0); PG8_BAR; PG8_MMA(0, 0, At, B0); PG8_MMA(0, 1, At, B1); PG8_BAR; PG8_SCHED;
            PG8_LDA(At, 1, 1); PG8_STAGE(PG8_SB(1, 0), b3, voffB); PG8_STAGE(PG8_SB(1, 1), b3 + hstep, voffB); PG8_STAGE(PG8_SA(1, 0), a3, voffA);
            PG8_WAIT_V(8); PG8_WAIT_L(0); PG8_BAR; PG8_MMA(1, 0, At, B0); PG8_MMA(1, 1, At, B1); PG8_BAR; PG8_SCHED;
            } else {
            PG8_LDB(B0, 0, 0); PG8_SCHED; PG8_LDA(At, 0, 0); PG8_STAGE(PG8_SA(1, 1), a1 + hstep, voffA);
            PG8_WAIT_L(8); PG8_BAR; PG8_WAIT_L(0); PG8_MMA(0, 0, At, B0); PG8_BAR; PG8_SCHED;
            PG8_LDB(B1, 0, 1); PG8_STAGE(PG8_SB(0, 0), b2, voffB);
            PG8_BAR; PG8_WAIT_L(0); PG8_MMA(0, 1, At, B1); PG8_BAR;
            PG8_LDA(At, 0, 1); PG8_STAGE(PG8_SA(0, 0), a2, voffA);
            PG8_BAR; PG8_WAIT_L(0); PG8_MMA(1, 0, At, B0); PG8_BAR; PG8_SCHED;
            PG8_STAGE(PG8_SB(0, 1), b2 + hstep, voffB);
            PG8_WAIT_V(6); PG8_BAR; PG8_MMA(1, 1, At, B1); PG8_BAR;
            PG8_LDB(B0, 1, 0); PG8_SCHED; PG8_LDA(At, 1, 0); PG8_STAGE(PG8_SA(0, 1), a2 + hstep, voffA);
            PG8_WAIT_L(8); PG8_BAR; PG8_WAIT_L(0); PG8_MMA(0, 0, At, B0); PG8_BAR; PG8_SCHED;
            PG8_LDB(B1, 1, 1); PG8_STAGE(PG8_SB(1, 0), b3, voffB);
            PG8_BAR; PG8_WAIT_L(0); PG8_MMA(0, 1, At, B1); PG8_BAR;
            PG8_LDA(At, 1, 1); PG8_STAGE(PG8_SA(1, 0), a3, voffA);
            PG8_BAR; PG8_WAIT_L(0); PG8_MMA(1, 0, At, B0); PG8_BAR; PG8_SCHED;
            PG8_STAGE(PG8_SB(1, 1), b3 + hstep, voffB);
            PG8_WAIT_V(6); PG8_BAR; PG8_MMA(1, 1, At, B1); PG8_BAR;
            }
        }
        if constexpr (ALIGN_EPI) { if (wr == 0) PG8_BAR; }
        E(acc, cur, wr, wc, fr, fq); S.done(cur);
        if (!has_next) break;
#pragma unroll
        for (int a = 0; a < 2; ++a)
#pragma unroll
            for (int b = 0; b < 2; ++b)
#pragma unroll
                for (int m = 0; m < 4; ++m)
#pragma unroll
                    for (int n = 0; n < 2; ++n) acc[a][b][m][n] = (f32x4){0.f, 0.f, 0.f, 0.f};
        cur = nxt; cA = nA; cB = nB; ++ui;
        if constexpr (ALIGN_EPI) { if (wr == 1) PG8_BAR; }
    }
    PG8_WAIT_V(0);
    if constexpr (!ALIGN_EPI) { if (wr == 0) PG8_BAR; }
    PG8_BAR;
#undef PG8_SA
#undef PG8_SB
#undef PG8_STAGE
#undef PG8_LDA
#undef PG8_LDB
#undef PG8_MMA
#undef PG8_WAIT_V
#undef PG8_WAIT_L
#undef PG8_BAR
#undef PG8_SCHED
}
}

constexpr int NWAVES = 8, NTHR = NWAVES * 64;
constexpr int DM = 1024, BATCH = 8, SEQ = 2048, DEPTH = 2, DECB = 128, PAST = 16384;
constexpr int MP = BATCH * SEQ;
constexpr int MT = MP + DECB;
constexpr int MPAD = 16640;
constexpr int NIN = 7168, MIXW = 2048, CH = 128, NH = 8, HD = 128, NCH = SEQ / CH;
constexpr float EPS = 1e-6f;

constexpr size_t MiB = 1u << 20;
constexpr size_t WS_CTL = 0, CTL_ZERO_BYTES = 64 * 1024;
constexpr size_t WS_WT1 = 1 * MiB;
constexpr size_t WS_WT2 = 29 * MiB;
constexpr size_t WS_WG  = 37 * MiB;
constexpr size_t WS_ROPE = 37 * MiB + 512 * 1024;
constexpr size_t WS_RS  = 39 * MiB;
constexpr size_t WS_LNS = 41 * MiB;
constexpr size_t WS_XB  = 44 * MiB;
constexpr size_t WS_H32 = 77 * MiB;
constexpr size_t PROJ_BYTES = (size_t)MPAD * 1024 * 2;
constexpr size_t WS_Q   = 142 * MiB;
constexpr size_t WS_K   = WS_Q + PROJ_BYTES;
constexpr size_t WS_V   = WS_K + PROJ_BYTES;
constexpr size_t WS_SGR = WS_V + PROJ_BYTES;
constexpr size_t WS_UG  = WS_SGR + PROJ_BYTES;
constexpr size_t WS_VG  = WS_UG + PROJ_BYTES;
constexpr size_t WS_CAT = 337 * MiB;
constexpr size_t WS_ST  = 402 * MiB;
constexpr size_t WS_END = 434 * MiB;
static_assert(WS_VG + PROJ_BYTES <= WS_CAT && WS_H32 + (size_t)MT * 1024 * 4 <= WS_Q && WS_XB + PROJ_BYTES <= WS_H32, "ws map");

constexpr size_t OUT_Y   = 0;
constexpr size_t OUT_SP  = (size_t)MT * 1024;
constexpr size_t OUT_SS  = OUT_SP + (size_t)DEPTH * BATCH * NH * HD * HD;
constexpr size_t OUT_GV  = OUT_SS + (size_t)DEPTH * DECB * NH * HD * HD;

constexpr int RING_OFF = 0, RING_BYTES = 131072;
constexpr int LDS_BYTES = 147456;
constexpr int MISC_OFF = LDS_BYTES - 512;

#define GAS __attribute__((address_space(1)))
#define LAS __attribute__((address_space(3)))
typedef unsigned short bf16;
typedef unsigned v4u __attribute__((ext_vector_type(4)));
typedef unsigned v2u __attribute__((ext_vector_type(2)));
typedef float f32x4 __attribute__((ext_vector_type(4)));
typedef float f32x2 __attribute__((ext_vector_type(2)));
#define LDS_WAIT() asm volatile("s_waitcnt lgkmcnt(0)" ::: "memory")
__device__ __forceinline__ unsigned f2bf(float f) { unsigned u = __builtin_bit_cast(unsigned, f); return (u + 0x7fffu + ((u >> 16) & 1u)) >> 16; }
__device__ __forceinline__ unsigned pk2(float lo, float hi) { return f2bf(lo) | (f2bf(hi) << 16); }
__device__ __forceinline__ float bf2f(unsigned b) { return __builtin_bit_cast(float, b << 16); }
__device__ __forceinline__ float bflo(unsigned w) { return __builtin_bit_cast(float, w << 16); }
__device__ __forceinline__ float bfhi(unsigned w) { return __builtin_bit_cast(float, w & 0xffff0000u); }
__device__ __forceinline__ float silu_f(float x) { return x / (1.0f + __expf(-x)); }
__device__ __forceinline__ float wave_sum(float v) {
#pragma unroll
    for (int o = 1; o < 64; o <<= 1) v += __shfl_xor(v, o);
    return v;
}
__device__ __forceinline__ float lg2gamma(int h) {
    return h == 0 ? -0.04580368961312479f : h == 1 ? -0.02272007650008353f : h == 2 ? -0.011315313227834146f : h == 3 ? -0.005646563141142063f :
           h == 4 ? -0.0028205190623786626f : h == 5 ? -0.0014095702546713536f : h == 6 ? -0.0007046129765893727f : -0.0003522634716290214f;
}

#define XB_TMO      128
#define XB_XCNT(j)  (256  + 64 * (j))
#define XB_XSUB(j)  (1280 + 64 * (j))
#define XB_XGEN(j)  (2304 + 64 * (j))
#define XB_TOP      3328
#define XB_TOPGEN   3392
#define XCD_BAR_WORDS 3456
#define XB_SPIN_CAP (1u << 18)
__device__ __forceinline__ unsigned xb_ld(unsigned* p)              { return __hip_atomic_load(p, __ATOMIC_RELAXED, __HIP_MEMORY_SCOPE_AGENT); }
__device__ __forceinline__ unsigned xb_add(unsigned* p, unsigned v) { return __hip_atomic_fetch_add(p, v, __ATOMIC_RELAXED, __HIP_MEMORY_SCOPE_AGENT); }
__device__ __forceinline__ unsigned xb_xcc_id() { return (unsigned)__builtin_amdgcn_s_getreg((3 << 11) | 20) & 0xFu; }
#define XB_SPIN(cond, bar) do { unsigned _sp = 0; while (cond) { __builtin_amdgcn_s_sleep(1); \
    if ((++_sp & 255u) == 0u) { if (xb_ld(&(bar)[XB_TMO])) break; if (_sp > XB_SPIN_CAP) { atomicAdd(&(bar)[XB_TMO], 1u); break; } } } } while (0)
struct XcdBarrier { unsigned* bar; unsigned x; volatile LAS unsigned* st; };
__device__ __forceinline__ XcdBarrier xcd_barrier_post(unsigned* bar, volatile LAS unsigned* st) {
    XcdBarrier b; b.bar = bar; b.x = xb_xcc_id(); b.st = st;
    if (threadIdx.x == 0) (void)xb_add(&bar[XB_XCNT(b.x)], 1u);
    return b;
}
__device__ __forceinline__ void xcd_barrier_complete(unsigned* bar, unsigned x, unsigned& nloc, unsigned& nx) {
    const unsigned G = gridDim.x * gridDim.y * gridDim.z;
    unsigned sum, cnt, mine, sp = 0u;
    for (;;) {
        sum = 0u; cnt = 0u; mine = 0u;
#pragma unroll
        for (unsigned j = 0; j < 16; ++j) { const unsigned c = xb_ld(&bar[XB_XCNT(j)]); sum += c; cnt += (c > 0u) ? 1u : 0u; mine = (j == x) ? c : mine; }
        if (sum == G) break;
        __builtin_amdgcn_s_sleep(1);
        if ((++sp & 255u) == 0u) { if (xb_ld(&bar[XB_TMO])) break; if (sp > XB_SPIN_CAP) { atomicAdd(&bar[XB_TMO], 1u); break; } }
    }
    nloc = mine > 0u ? mine : 1u; nx = cnt > 0u ? cnt : 1u;
}
__device__ __forceinline__ void xcd_barrier(const XcdBarrier& b) {
    asm volatile("s_waitcnt vmcnt(0)" ::: "memory");
    __syncthreads();
    if (threadIdx.x == 0) {
        unsigned* bar = b.bar;
        __builtin_amdgcn_s_waitcnt(0);
        unsigned nloc = b.st[0], nx = b.st[1];
        if (nloc == 0u) { xcd_barrier_complete(bar, b.x, nloc, nx); b.st[0] = nloc; b.st[1] = nx; }
        const unsigned old = xb_add(&bar[XB_XSUB(b.x)], 1u);
        const unsigned gen = old / nloc;
        if (old + 1u == (gen + 1u) * nloc) {
            __builtin_amdgcn_fence(__ATOMIC_RELEASE, "agent");
            asm volatile("s_waitcnt vmcnt(0)" ::: "memory");
            const unsigned og = xb_add(&bar[XB_TOP], 1u);
            const unsigned tg = og / nx;
            if (og + 1u == (tg + 1u) * nx) xb_add(&bar[XB_TOPGEN], 1u);
            else XB_SPIN(xb_ld(&bar[XB_TOPGEN]) == tg, bar);
            __builtin_amdgcn_fence(__ATOMIC_ACQUIRE, "agent");
            xb_add(&bar[XB_XGEN(b.x)], 1u);
            asm volatile("s_waitcnt vmcnt(0)" ::: "memory");
        } else {
            XB_SPIN(xb_ld(&bar[XB_XGEN(b.x)]) == gen, bar);
            __builtin_amdgcn_fence(__ATOMIC_ACQUIRE, "agent");
            asm volatile("s_waitcnt vmcnt(0)" ::: "memory");
        }
    }
    __syncthreads();
}

struct EpiProj {
    static constexpr bool PERM = true;
    unsigned char* ws;
    __device__ __forceinline__ void operator()(const pg8::f32x4 (&acc)[2][2][4][2], const pg8::Unit& u, int wr, int wc, int fr, int fq) const {
        bf16* const Q = (bf16*)(ws + WS_Q); bf16* const K = (bf16*)(ws + WS_K); bf16* const V = (bf16*)(ws + WS_V); bf16* const SGR = (bf16*)(ws + WS_SGR);
        bf16* const UG = (bf16*)(ws + WS_UG); bf16* const VG = (bf16*)(ws + WS_VG); const float* const RS = (const float*)(ws + WS_RS); float* const LNS = (float*)(ws + WS_LNS);
        const float* const rope = (const float*)(ws + WS_ROPE);
        const int pn = u.pn, rowb = u.pm * 256 + wr * 64 + fr;
#pragma unroll
        for (int ai = 0; ai < 2; ++ai)
#pragma unroll
            for (int m = 0; m < 4; ++m) {
                const int row = rowb + ai * 128 + m * 16;
                const f32x4* rp = (const f32x4*)(RS + (size_t)row * 16);
                const f32x4 r0 = rp[0], r1 = rp[1], r2 = rp[2], r3 = rp[3];
                const float ssq = ((r0.x + r0.y) + (r0.z + r0.w)) + ((r1.x + r1.y) + (r1.z + r1.w)) + ((r2.x + r2.y) + (r2.z + r2.w)) + ((r3.x + r3.y) + (r3.z + r3.w));
                const float rr = rsqrtf(ssq * (1.0f / 1024.0f) + EPS);
                if (pn < 8) {
                    const int head = 2 * (pn & 3) + (wc >> 1), f0 = 32 * (wc & 1) + 8 * fq;
                    const int pidx = row < MP ? (row & (SEQ - 1)) : SEQ;
                    const int ci = row < MP ? (row & (CH - 1)) : 0;
                    const float e = lg2gamma(head) * (float)(ci + 1);
                    const float sc = rr * (pn < 4 ? exp2f(e) : exp2f(-e) * 0.08838834764831845f);
                    const f32x4* cs = (const f32x4*)(rope + ((size_t)pidx * 64 + f0) * 2);
                    float o1[8], o2[8];
#pragma unroll
                    for (int t = 0; t < 4; ++t) { const f32x4 c4 = cs[t];
                        const int e0 = 2 * t, e1 = 2 * t + 1;
                        const float a0 = acc[ai][0][m][e0 >> 2][e0 & 3], b0 = acc[ai][1][m][e0 >> 2][e0 & 3];
                        const float a1 = acc[ai][0][m][e1 >> 2][e1 & 3], b1 = acc[ai][1][m][e1 >> 2][e1 & 3];
                        o1[e0] = (a0 * c4.x - b0 * c4.y) * sc; o2[e0] = (a0 * c4.y + b0 * c4.x) * sc;
                        o1[e1] = (a1 * c4.z - b1 * c4.w) * sc; o2[e1] = (a1 * c4.w + b1 * c4.z) * sc; }
                    bf16* dst = (pn < 4 ? Q : K) + (size_t)row * 1024 + 128 * head + f0;
                    pg8::u32x4 w1, w2;
                    w1.x = pg8::cvt_pk_bf16(o1[0], o1[1]); w1.y = pg8::cvt_pk_bf16(o1[2], o1[3]); w1.z = pg8::cvt_pk_bf16(o1[4], o1[5]); w1.w = pg8::cvt_pk_bf16(o1[6], o1[7]);
                    w2.x = pg8::cvt_pk_bf16(o2[0], o2[1]); w2.y = pg8::cvt_pk_bf16(o2[2], o2[3]); w2.z = pg8::cvt_pk_bf16(o2[4], o2[5]); w2.w = pg8::cvt_pk_bf16(o2[6], o2[7]);
                    *(pg8::u32x4*)dst = w1; *(pg8::u32x4*)(dst + 64) = w2;
                } else if (pn < 16) {
                    const bool isv = pn < 12;
                    bf16* dst = (isv ? V : SGR) + (size_t)row * 1024 + 256 * (isv ? pn - 8 : pn - 12) + 32 * wc + 8 * fq;
#pragma unroll
                    for (int bj = 0; bj < 2; ++bj) { f32x4 v0 = acc[ai][bj][m][0] * rr, v1 = acc[ai][bj][m][1] * rr;
                        if (!isv) {
#pragma unroll
                            for (int j = 0; j < 4; ++j) { v0[j] = silu_f(v0[j]); v1[j] = silu_f(v1[j]); } }
                        pg8::u32x4 w; w.x = pg8::cvt_pk_bf16(v0[0], v0[1]); w.y = pg8::cvt_pk_bf16(v0[2], v0[3]); w.z = pg8::cvt_pk_bf16(v1[0], v1[1]); w.w = pg8::cvt_pk_bf16(v1[2], v1[3]);
                        *(pg8::u32x4*)(dst + 128 * bj) = w; }
                } else if (pn < 24) {
                    bf16* dst = UG + (size_t)row * 1024 + 128 * (pn - 16) + 32 * wc + 8 * fq;
                    f32x4 v0 = acc[ai][0][m][0] * rr, v1 = acc[ai][0][m][1] * rr; const f32x4 g0 = acc[ai][1][m][0] * rr, g1 = acc[ai][1][m][1] * rr;
#pragma unroll
                    for (int j = 0; j < 4; ++j) { v0[j] *= silu_f(g0[j]); v1[j] *= silu_f(g1[j]); }
                    pg8::u32x4 w; w.x = pg8::cvt_pk_bf16(v0[0], v0[1]); w.y = pg8::cvt_pk_bf16(v0[2], v0[3]); w.z = pg8::cvt_pk_bf16(v1[0], v1[1]); w.w = pg8::cvt_pk_bf16(v1[2], v1[3]);
                    *(pg8::u32x4*)dst = w;
                } else {
                    bf16* dst = VG + (size_t)row * 1024 + 256 * (pn - 24) + 32 * wc + 8 * fq;
                    float s1 = 0.f, s2 = 0.f;
#pragma unroll
                    for (int bj = 0; bj < 2; ++bj) { const f32x4 v0 = acc[ai][bj][m][0] * rr, v1 = acc[ai][bj][m][1] * rr;
#pragma unroll
                        for (int j = 0; j < 4; ++j) { s1 += v0[j] + v1[j]; s2 += v0[j] * v0[j] + v1[j] * v1[j]; }
                        pg8::u32x4 w; w.x = pg8::cvt_pk_bf16(v0[0], v0[1]); w.y = pg8::cvt_pk_bf16(v0[2], v0[3]); w.z = pg8::cvt_pk_bf16(v1[0], v1[1]); w.w = pg8::cvt_pk_bf16(v1[2], v1[3]);
                        *(pg8::u32x4*)(dst + 128 * bj) = w; }
                    s1 += __shfl_xor(s1, 16); s1 += __shfl_xor(s1, 32); s2 += __shfl_xor(s2, 16); s2 += __shfl_xor(s2, 32);
                    if (fq == 0) *(f32x2*)(LNS + ((size_t)row * 16 + (pn - 24) * 4 + wc) * 2) = (f32x2){s1, s2};
                }
            }
    }
};
struct EpiRes {
    static constexpr bool PERM = false;
    const float* res_p; const float* res_s; float* out; unsigned char* ws;
    __device__ __forceinline__ void operator()(const pg8::f32x4 (&acc)[2][2][4][2], const pg8::Unit& u, int wr, int wc, int fr, int fq) const {
        bf16* const XB = (bf16*)(ws + WS_XB); float* const RS = (float*)(ws + WS_RS);
        const int rowb = u.pm * 256 + wr * 64 + fr, colb = u.pn * 256 + wc * 32 + 4 * fq;
#pragma unroll
        for (int ai = 0; ai < 2; ++ai)
#pragma unroll
            for (int m = 0; m < 4; ++m) {
                const int row = rowb + ai * 128 + m * 16; const bool ok = row < MT;
                float ssq = 0.f;
                if (ok) {
                    const float* rsrc = (row < MP ? res_p + (size_t)row * 1024 : res_s + (size_t)(row - MP) * 1024) + colb;
                    float* o = out + (size_t)row * 1024 + colb; bf16* xb = XB + (size_t)row * 1024 + colb;
#pragma unroll
                    for (int bj = 0; bj < 2; ++bj)
#pragma unroll
                        for (int n = 0; n < 2; ++n) { const f32x4 hn = *(const f32x4*)(rsrc + bj * 128 + n * 16) + acc[ai][bj][m][n];
                            *(f32x4*)(o + bj * 128 + n * 16) = hn; ssq += (hn.x * hn.x + hn.y * hn.y) + (hn.z * hn.z + hn.w * hn.w);
                            pg8::u32x2 w; w.x = pg8::cvt_pk_bf16(hn.x, hn.y); w.y = pg8::cvt_pk_bf16(hn.z, hn.w); *(pg8::u32x2*)(xb + bj * 128 + n * 16) = w; }
                }
                ssq += __shfl_xor(ssq, 16); ssq += __shfl_xor(ssq, 32);
                if (ok && fq == 0) RS[(size_t)row * 16 + u.pn * 4 + wc] = ssq;
            }
    }
};

struct Args { const float* in[11]; float* out; unsigned char* ws; int ph_lo, ph_hi; };

#define CAS __attribute__((address_space(4)))
__device__ __forceinline__ Args fresh_args() { const unsigned long long p0 = (unsigned long long)__builtin_amdgcn_kernarg_segment_ptr();
    unsigned plo = __builtin_amdgcn_readfirstlane((unsigned)p0), phi = __builtin_amdgcn_readfirstlane((unsigned)(p0 >> 32)); asm volatile("" : "+s"(plo), "+s"(phi));
    const CAS Args* q = (const CAS Args*)(((unsigned long long)phi << 32) | plo); Args r;
#pragma unroll
    for (int i = 0; i < 11; ++i) r.in[i] = q->in[i];
    r.out = q->out; r.ws = q->ws; r.ph_lo = q->ph_lo; r.ph_hi = q->ph_hi; return r; }
__device__ __forceinline__ int colmap(int np) {
    const int pn = np >> 8, tc = np & 255;
    if (pn < 8) { const int base = (pn < 4) ? 0 : 1024, head = 2 * (pn & 3) + ((tc & 127) >> 6), part = tc >> 7; return base + 128 * head + 64 * part + (tc & 63); }
    if (pn < 12) return 2048 + 256 * (pn - 8) + tc;
    if (pn < 16) return 3072 + 256 * (pn - 12) + tc;
    if (pn < 24) { const int head = pn - 16; return tc < 128 ? 4096 + 128 * head + tc : 6144 + 128 * head + (tc - 128); }
    return 5120 + 256 * (pn - 24) + tc;
}
__device__ __forceinline__ void p0_transpose_item(const float* W, int K, int N, bf16* WT, const float* gk, int k0, int src_n0, int dst_n0, LAS float* scr, int lane) {
#pragma unroll 8
    for (int i = 0; i < 32; ++i) { const int kk = 2 * i + (lane >> 5); float v = W[(size_t)(k0 + kk) * N + src_n0 + (lane & 31)]; if (gk) v *= gk[k0 + kk]; scr[kk * 33 + (lane & 31)] = v; }
    LDS_WAIT(); asm volatile("" ::: "memory");
    const int c = lane & 7;
#pragma unroll
    for (int j = 0; j < 4; ++j) { const int n = (lane >> 3) + 8 * j; const LAS float* s = scr + (8 * c) * 33 + n;
        v4u o; o.x = pk2(s[0 * 33], s[1 * 33]); o.y = pk2(s[2 * 33], s[3 * 33]); o.z = pk2(s[4 * 33], s[5 * 33]); o.w = pk2(s[6 * 33], s[7 * 33]);
        *(v4u*)(WT + (size_t)(dst_n0 + n) * K + k0 + 8 * c) = o; }
    LDS_WAIT(); asm volatile("" ::: "memory");
}
__device__ __forceinline__ void p0_prologue(const Args& a, LAS unsigned char* lds, int gw, int NGW, int lane, int wave) {
    LAS float* scr = (LAS float*)(lds + RING_OFF + wave * 16384);
    unsigned char* ws = a.ws;
    constexpr int I1 = (DM / 64) * (NIN / 32), I2 = (MIXW / 64) * (DM / 32), NITEMS = DEPTH * (I1 + I2);
    for (int it = gw; it < NITEMS; it += NGW) {
        const int l = it / (I1 + I2); int r = it % (I1 + I2);
        if (r < I1) { const int kb = r / (NIN / 32), nb = r % (NIN / 32);
            p0_transpose_item(a.in[4] + (size_t)l * DM * NIN, DM, NIN, (bf16*)(ws + WS_WT1) + (size_t)l * NIN * DM, a.in[3] + l * DM, 64 * kb, colmap(32 * nb), 32 * nb, scr, lane); }
        else { r -= I1; const int kb = r / (DM / 32), nb = r % (DM / 32);
            p0_transpose_item(a.in[5] + (size_t)l * MIXW * DM, MIXW, DM, (bf16*)(ws + WS_WT2) + (size_t)l * DM * MIXW, nullptr, 64 * kb, 32 * nb, 32 * nb, scr, lane); }
    }
    for (int m = gw; m < MT; m += NGW) {
        const float* xrow = m < MP ? a.in[0] + (size_t)m * DM : a.in[1] + (size_t)(m - MP) * DM;
        const f32x4* xr = (const f32x4*)xrow + lane; f32x4 v[4]; float s = 0.f;
#pragma unroll
        for (int j = 0; j < 4; ++j) { v[j] = xr[64 * j]; s += (v[j].x * v[j].x + v[j].y * v[j].y) + (v[j].z * v[j].z + v[j].w * v[j].w); }
        s = wave_sum(s);
        unsigned long long* o8 = (unsigned long long*)((bf16*)(ws + WS_XB) + (size_t)m * DM) + lane;
#pragma unroll
        for (int j = 0; j < 4; ++j) o8[64 * j] = (unsigned long long)pk2(v[j].x, v[j].y) | ((unsigned long long)pk2(v[j].z, v[j].w) << 32);
        if (lane < 16) ((float*)(ws + WS_RS))[(size_t)m * 16 + lane] = lane == 0 ? s : 0.f;
    }
    const int gt = gw * 64 + lane, NGT = NGW * 64;
    for (int i = gt; i < (SEQ + 1) * 64; i += NGT) {
        const int pidx = i >> 6, f = i & 63; const double pos = pidx < SEQ ? (double)pidx : (double)PAST;
        double inv = 1.0; for (int j = 0; j < f; ++j) inv *= 0.8659643233600653;
        const double ang = pos * inv; const double q = __builtin_rint(ang * 0.63661977236758134308);
        double r = __builtin_fma(-q, 1.5707963267948966, ang); r = __builtin_fma(-q, 6.123233995736766e-17, r);
        const double r2 = r * r;
        const double sn = r * (1.0 + r2 * (-1.0 / 6 + r2 * (1.0 / 120 + r2 * (-1.0 / 5040 + r2 * (1.0 / 362880 + r2 * (-1.0 / 39916800 + r2 * (1.0 / 6227020800.0)))))));
        const double cs = 1.0 + r2 * (-0.5 + r2 * (1.0 / 24 + r2 * (-1.0 / 720 + r2 * (1.0 / 40320 + r2 * (-1.0 / 3628800 + r2 * (1.0 / 479001600.0))))));
        const int qi = ((int)q) & 3;
        const double c = qi == 0 ? cs : qi == 1 ? -sn : qi == 2 ? -cs : sn;
        const double s = qi == 0 ? sn : qi == 1 ? cs : qi == 2 ? -sn : -cs;
        ((f32x2*)(ws + WS_ROPE))[i] = (f32x2){(float)c, (float)s};
    }
    for (int i = gt; i < DEPTH * NH * CH * CH; i += NGT) { const int jj = i & 127, ii = (i >> 7) & 127; ((bf16*)(ws + WS_WG))[i] = jj <= ii ? (bf16)f2bf(a.in[6][i]) : (bf16)0; }
}

constexpr int LP = 136;
constexpr int TILE_B = 128 * LP * 2;
__device__ __forceinline__ void load_tile_bf16(LAS bf16* dst, const bf16* src, int ld, int tid) {
#pragma unroll
    for (int i = 0; i < 4; ++i) { const int ch = tid + i * NTHR, r = ch >> 4, c = (ch & 15) * 8; *(LAS v4u*)(dst + r * LP + c) = *(const v4u*)(src + (size_t)r * ld + c); }
}
__device__ __forceinline__ void kvscan_item(const Args& a, int l, int item, LAS unsigned char* lds, int tid) {
    const int b = item >> 5, h = (item >> 2) & 7, dq = item & 3;
    LAS bf16* Ks = (LAS bf16*)lds; LAS bf16* Vs = (LAS bf16*)(lds + TILE_B);
    const bf16* Kg = (const bf16*)(a.ws + WS_K); const bf16* Vg = (const bf16*)(a.ws + WS_V); bf16* ST = (bf16*)(a.ws + WS_ST);
    const int dvl = tid & 31, dkg = tid >> 5, dv = dq * 32 + dvl;
    float S[8];
#pragma unroll
    for (int e = 0; e < 8; ++e) S[e] = 0.f;
    const float g128 = exp2f(lg2gamma(h) * 128.0f);
    for (int c = 0; c < NCH; ++c) {
        const size_t row0 = (size_t)b * SEQ + c * CH;
        { v4u w; w.x = pk2(S[0], S[1]); w.y = pk2(S[2], S[3]); w.z = pk2(S[4], S[5]); w.w = pk2(S[6], S[7]);
          *(v4u*)(ST + ((((size_t)b * NCH + c) * NH + h) * HD + dv) * HD + dkg * 8) = w; }
        __syncthreads();
        load_tile_bf16(Ks, Kg + row0 * 1024 + 128 * h, 1024, tid);
        load_tile_bf16(Vs, Vg + row0 * 1024 + 128 * h, 1024, tid);
        __syncthreads();
        for (int j = 0; j < CH; ++j) {
            const v4u kk = *(const LAS v4u*)(Ks + j * LP + dkg * 8); const float vv = bf2f(Vs[j * LP + dv]);
            S[0] += bflo(kk.x) * vv; S[1] += bfhi(kk.x) * vv; S[2] += bflo(kk.y) * vv; S[3] += bfhi(kk.y) * vv;
            S[4] += bflo(kk.z) * vv; S[5] += bfhi(kk.z) * vv; S[6] += bflo(kk.w) * vv; S[7] += bfhi(kk.w) * vv;
        }
#pragma unroll
        for (int e = 0; e < 8; ++e) S[e] *= g128;
    }
    float* so = a.out + OUT_SP + ((((size_t)l * BATCH + b) * NH + h) * HD) * HD;
#pragma unroll
    for (int e = 0; e < 8; ++e) so[(size_t)(dkg * 8 + e) * HD + dv] = S[e];
    __syncthreads();
}
__device__ __forceinline__ void sample_ret_item(const Args& a, int l, int item, int lane) {
    const int b = item >> 3, h = item & 7; const size_t row = (size_t)MP + b;
    const bf16* Qg = (const bf16*)(a.ws + WS_Q) + row * 1024 + 128 * h; const bf16* Kg = (const bf16*)(a.ws + WS_K) + row * 1024 + 128 * h;
    const bf16* Vg = (const bf16*)(a.ws + WS_V) + row * 1024 + 128 * h; const bf16* Gg = (const bf16*)(a.ws + WS_SGR) + row * 1024 + 128 * h;
    const float* S0 = a.in[2] + ((((size_t)l * DECB + b) * NH + h) * HD) * HD; float* S1 = a.out + OUT_SS + ((((size_t)l * DECB + b) * NH + h) * HD) * HD;
    const int c4 = lane & 31, r2 = lane >> 5; const float gam = exp2f(lg2gamma(h));
    const v2u vw = *(const v2u*)(Vg + 4 * c4); const float v0 = bflo(vw.x), v1 = bfhi(vw.x), v2 = bflo(vw.y), v3 = bfhi(vw.y);
    f32x4 o = {0.f, 0.f, 0.f, 0.f};
#pragma unroll 8
    for (int t = 0; t < 64; ++t) {
        const int d = 2 * t + r2; const float qd = bf2f(Qg[d]), kd = bf2f(Kg[d]);
        const f32x4 s0 = *(const f32x4*)(S0 + (size_t)d * HD + 4 * c4);
        f32x4 t1; t1.x = s0.x + kd * v0; t1.y = s0.y + kd * v1; t1.z = s0.z + kd * v2; t1.w = s0.w + kd * v3;
        o += t1 * qd; *(f32x4*)(S1 + (size_t)d * HD + 4 * c4) = t1 * gam;
    }
    o.x += __shfl_xor(o.x, 32); o.y += __shfl_xor(o.y, 32); o.z += __shfl_xor(o.z, 32); o.w += __shfl_xor(o.w, 32);
    float ss = (o.x * o.x + o.y * o.y) + (o.z * o.z + o.w * o.w);
#pragma unroll
    for (int s = 1; s < 32; s <<= 1) ss += __shfl_xor(ss, s);
    const float rs = rsqrtf(ss * (1.0f / 128.0f) + EPS);
    const v2u gw = *(const v2u*)(Gg + 4 * c4);
    if (r2 == 0) { v2u w; w.x = pk2(o.x * rs * bflo(gw.x), o.y * rs * bfhi(gw.x)); w.y = pk2(o.z * rs * bflo(gw.y), o.w * rs * bfhi(gw.y));
        *(v2u*)((bf16*)(a.ws + WS_CAT) + row * 2048 + 128 * h + 4 * c4) = w; }
}
__device__ __forceinline__ void sample_gm_item(const Args& a, int l, int b, int lane) {
    const size_t row = (size_t)MP + b;
    const float* lp = (const float*)(a.ws + WS_LNS) + row * 32; float s1 = 0.f, s2 = 0.f;
#pragma unroll
    for (int i = 0; i < 16; ++i) { s1 += lp[2 * i]; s2 += lp[2 * i + 1]; }
    const float mu = s1 * (1.0f / 1024.0f), var = s2 * (1.0f / 1024.0f) - mu * mu, rstd = rsqrtf(var + EPS);
    const bf16* vg = (const bf16*)(a.ws + WS_VG) + row * 1024; const bf16* ug = (const bf16*)(a.ws + WS_UG) + row * 1024;
    float* gv = a.out + OUT_GV + ((size_t)l * DECB + b) * 1024; bf16* cat = (bf16*)(a.ws + WS_CAT) + row * 2048 + 1024;
#pragma unroll
    for (int j = 0; j < 4; ++j) { const int c = 4 * lane + 256 * j, h = c >> 7;
        const v2u vw = *(const v2u*)(vg + c), uw = *(const v2u*)(ug + c);
        const f32x4 lg = *(const f32x4*)(a.in[8] + l * 1024 + c), lb = *(const f32x4*)(a.in[9] + l * 1024 + c);
        f32x4 vn; vn.x = (bflo(vw.x) - mu) * rstd * lg.x + lb.x; vn.y = (bfhi(vw.x) - mu) * rstd * lg.y + lb.y; vn.z = (bflo(vw.y) - mu) * rstd * lg.z + lb.z; vn.w = (bfhi(vw.y) - mu) * rstd * lg.w + lb.w;
        *(f32x4*)(gv + c) = vn;
        const float w00 = a.in[6][((size_t)l * NH + h) * CH * CH], b0 = a.in[7][((size_t)l * NH + h) * CH];
        v2u w; w.x = pk2((w00 * vn.x + b0) * bflo(uw.x), (w00 * vn.y + b0) * bfhi(uw.x)); w.y = pk2((w00 * vn.z + b0) * bflo(uw.y), (w00 * vn.w + b0) * bfhi(uw.y));
        *(v2u*)(cat + c) = w; }
}
__device__ __forceinline__ void ret_item(const Args& a, int l, int item, LAS unsigned char* lds, int tid) {
    const int b = item >> 7, c = (item >> 3) & 15, h = item & 7; const size_t row0 = (size_t)b * SEQ + c * CH;
    LAS bf16* Qs = (LAS bf16*)lds; LAS bf16* Ks = (LAS bf16*)(lds + TILE_B); LAS bf16* SC = (LAS bf16*)(lds + 2 * TILE_B); LAS bf16* Ss = (LAS bf16*)(lds + 3 * TILE_B);
    __syncthreads();
    load_tile_bf16(Qs, (const bf16*)(a.ws + WS_Q) + row0 * 1024 + 128 * h, 1024, tid);
    load_tile_bf16(Ks, (const bf16*)(a.ws + WS_K) + row0 * 1024 + 128 * h, 1024, tid);
    { const bf16* ST = (const bf16*)(a.ws + WS_ST) + ((((size_t)b * NCH + c) * NH + h) * HD) * HD;
#pragma unroll
      for (int i = 0; i < 4; ++i) { const int ch = tid + i * NTHR, dv = ch >> 4, dk0 = (ch & 15) * 8; const v4u w = *(const v4u*)(ST + (size_t)dv * HD + dk0);
          Ss[(dk0 + 0) * LP + dv] = (bf16)(w.x & 0xffff); Ss[(dk0 + 1) * LP + dv] = (bf16)(w.x >> 16); Ss[(dk0 + 2) * LP + dv] = (bf16)(w.y & 0xffff); Ss[(dk0 + 3) * LP + dv] = (bf16)(w.y >> 16);
          Ss[(dk0 + 4) * LP + dv] = (bf16)(w.z & 0xffff); Ss[(dk0 + 5) * LP + dv] = (bf16)(w.z >> 16); Ss[(dk0 + 6) * LP + dv] = (bf16)(w.w & 0xffff); Ss[(dk0 + 7) * LP + dv] = (bf16)(w.w >> 16); } }
    __syncthreads();
    const int i = tid >> 2, jq = tid & 3;
    for (int jj = 0; jj < 32; ++jj) { const int j = 32 * jq + jj; float s = 0.f;
        if (j <= i) {
#pragma unroll 4
            for (int d8 = 0; d8 < 16; ++d8) { const v4u qa = *(const LAS v4u*)(Qs + i * LP + 8 * d8), kb = *(const LAS v4u*)(Ks + j * LP + 8 * d8);
                s += bflo(qa.x) * bflo(kb.x) + bfhi(qa.x) * bfhi(kb.x) + bflo(qa.y) * bflo(kb.y) + bfhi(qa.y) * bfhi(kb.y)
                   + bflo(qa.z) * bflo(kb.z) + bfhi(qa.z) * bfhi(kb.z) + bflo(qa.w) * bflo(kb.w) + bfhi(qa.w) * bfhi(kb.w); } }
        SC[i * LP + j] = (bf16)f2bf(s); }
    __syncthreads();
    load_tile_bf16(Ks, (const bf16*)(a.ws + WS_V) + row0 * 1024 + 128 * h, 1024, tid);
    __syncthreads();
    float o[32];
#pragma unroll
    for (int e = 0; e < 32; ++e) o[e] = 0.f;
    const int dq = jq;
    for (int j = 0; j <= i; ++j) { const float s = bf2f(SC[i * LP + j]);
#pragma unroll
        for (int g = 0; g < 4; ++g) { const v4u vv = *(const LAS v4u*)(Ks + j * LP + 32 * dq + 8 * g);
            o[8 * g + 0] += s * bflo(vv.x); o[8 * g + 1] += s * bfhi(vv.x); o[8 * g + 2] += s * bflo(vv.y); o[8 * g + 3] += s * bfhi(vv.y);
            o[8 * g + 4] += s * bflo(vv.z); o[8 * g + 5] += s * bfhi(vv.z); o[8 * g + 6] += s * bflo(vv.w); o[8 * g + 7] += s * bfhi(vv.w); } }
    for (int d = 0; d < HD; ++d) { const float s = bf2f(Qs[i * LP + d]);
#pragma unroll
        for (int g = 0; g < 4; ++g) { const v4u vv = *(const LAS v4u*)(Ss + d * LP + 32 * dq + 8 * g);
            o[8 * g + 0] += s * bflo(vv.x); o[8 * g + 1] += s * bfhi(vv.x); o[8 * g + 2] += s * bflo(vv.y); o[8 * g + 3] += s * bfhi(vv.y);
            o[8 * g + 4] += s * bflo(vv.z); o[8 * g + 5] += s * bfhi(vv.z); o[8 * g + 6] += s * bflo(vv.w); o[8 * g + 7] += s * bfhi(vv.w); } }
    float ss = 0.f;
#pragma unroll
    for (int e = 0; e < 32; ++e) ss += o[e] * o[e];
    ss += __shfl_xor(ss, 1); ss += __shfl_xor(ss, 2);
    const float rs = rsqrtf(ss * (1.0f / 128.0f) + EPS);
    const bf16* Gg = (const bf16*)(a.ws + WS_SGR) + (row0 + i) * 1024 + 128 * h + 32 * dq; bf16* cat = (bf16*)(a.ws + WS_CAT) + (row0 + i) * 2048 + 128 * h + 32 * dq;
#pragma unroll
    for (int g = 0; g < 4; ++g) { const v4u gg = *(const v4u*)(Gg + 8 * g); v4u w;
        w.x = pk2(o[8 * g + 0] * rs * bflo(gg.x), o[8 * g + 1] * rs * bfhi(gg.x)); w.y = pk2(o[8 * g + 2] * rs * bflo(gg.y), o[8 * g + 3] * rs * bfhi(gg.y));
        w.z = pk2(o[8 * g + 4] * rs * bflo(gg.z), o[8 * g + 5] * rs * bfhi(gg.z)); w.w = pk2(o[8 * g + 6] * rs * bflo(gg.w), o[8 * g + 7] * rs * bfhi(gg.w));
        *(v4u*)(cat + 8 * g) = w; }
}
__device__ __forceinline__ void gm_item(const Args& a, int l, int item, LAS unsigned char* lds, int tid) {
    const int b = item >> 7, c = (item >> 3) & 15, h = item & 7; const size_t row0 = (size_t)b * SEQ + c * CH;
    LAS bf16* VN = (LAS bf16*)lds; LAS bf16* WG = (LAS bf16*)(lds + TILE_B); LAS float* ST2 = (LAS float*)(lds + 2 * TILE_B);
    __syncthreads();
    if (tid < 128) { const float* lp = (const float*)(a.ws + WS_LNS) + (row0 + tid) * 32; float s1 = 0.f, s2 = 0.f;
#pragma unroll
        for (int i = 0; i < 16; ++i) { s1 += lp[2 * i]; s2 += lp[2 * i + 1]; }
        const float mu = s1 * (1.0f / 1024.0f), var = s2 * (1.0f / 1024.0f) - mu * mu; ST2[2 * tid] = mu; ST2[2 * tid + 1] = rsqrtf(var + EPS); }
    load_tile_bf16(WG, (const bf16*)(a.ws + WS_WG) + ((size_t)l * NH + h) * CH * CH, 128, tid);
    __syncthreads();
    { const bf16* vg = (const bf16*)(a.ws + WS_VG) + row0 * 1024 + 128 * h; const float* lg = a.in[8] + l * 1024 + 128 * h; const float* lb = a.in[9] + l * 1024 + 128 * h;
#pragma unroll
      for (int i = 0; i < 4; ++i) { const int ch = tid + i * NTHR, r = ch >> 4, c0 = (ch & 15) * 8; const v4u w = *(const v4u*)(vg + (size_t)r * 1024 + c0);
          const float mu = ST2[2 * r], rstd = ST2[2 * r + 1]; const f32x4 g0 = *(const f32x4*)(lg + c0), g1 = *(const f32x4*)(lg + c0 + 4), b0 = *(const f32x4*)(lb + c0), b1 = *(const f32x4*)(lb + c0 + 4);
          v4u o; o.x = pk2((bflo(w.x) - mu) * rstd * g0.x + b0.x, (bfhi(w.x) - mu) * rstd * g0.y + b0.y); o.y = pk2((bflo(w.y) - mu) * rstd * g0.z + b0.z, (bfhi(w.y) - mu) * rstd * g0.w + b0.w);
          o.z = pk2((bflo(w.z) - mu) * rstd * g1.x + b1.x, (bfhi(w.z) - mu) * rstd * g1.y + b1.y); o.w = pk2((bflo(w.w) - mu) * rstd * g1.z + b1.z, (bfhi(w.w) - mu) * rstd * g1.w + b1.w);
          *(LAS v4u*)(VN + r * LP + c0) = o; } }
    __syncthreads();
    const int i = tid >> 2, dq = tid & 3;
    float o[32]; const float bi = a.in[7][((size_t)l * NH + h) * CH + i];
#pragma unroll
    for (int e = 0; e < 32; ++e) o[e] = bi;
    for (int j = 0; j <= i; ++j) { const float s = bf2f(WG[i * LP + j]);
#pragma unroll
        for (int g = 0; g < 4; ++g) { const v4u vv = *(const LAS v4u*)(VN + j * LP + 32 * dq + 8 * g);
            o[8 * g + 0] += s * bflo(vv.x); o[8 * g + 1] += s * bfhi(vv.x); o[8 * g + 2] += s * bflo(vv.y); o[8 * g + 3] += s * bfhi(vv.y);
            o[8 * g + 4] += s * bflo(vv.z); o[8 * g + 5] += s * bfhi(vv.z); o[8 * g + 6] += s * bflo(vv.w); o[8 * g + 7] += s * bfhi(vv.w); } }
    const bf16* Ug = (const bf16*)(a.ws + WS_UG) + (row0 + i) * 1024 + 128 * h + 32 * dq; bf16* cat = (bf16*)(a.ws + WS_CAT) + (row0 + i) * 2048 + 1024 + 128 * h + 32 * dq;
#pragma unroll
    for (int g = 0; g < 4; ++g) { const v4u gg = *(const v4u*)(Ug + 8 * g); v4u w;
        w.x = pk2(o[8 * g + 0] * bflo(gg.x), o[8 * g + 1] * bfhi(gg.x)); w.y = pk2(o[8 * g + 2] * bflo(gg.y), o[8 * g + 3] * bfhi(gg.y));
        w.z = pk2(o[8 * g + 4] * bflo(gg.z), o[8 * g + 5] * bfhi(gg.z)); w.w = pk2(o[8 * g + 6] * bflo(gg.w), o[8 * g + 7] * bfhi(gg.w));
        *(v4u*)(cat + 8 * g) = w; }
}

constexpr int NPHASE = 10;
__global__ void __launch_bounds__(NTHR, 2) fwd_kernel(Args args) {
    extern __shared__ __attribute__((aligned(16))) unsigned char lds_raw[];
    LAS unsigned char* lds = (LAS unsigned char*)lds_raw;
    volatile LAS unsigned* MISC = (volatile LAS unsigned*)(lds + MISC_OFF);
    const int G = gridDim.x, bx = blockIdx.x, NGW = G * NWAVES;
    if (threadIdx.x < 128) MISC[threadIdx.x] = 0u;
#define PHASE_IDS() int tid = threadIdx.x; asm volatile("" : "+v"(tid)); const int lane = tid & 63, wave = __builtin_amdgcn_readfirstlane(tid >> 6), gw = bx * NWAVES + wave; (void)lane; (void)gw
    __syncthreads();
#if MK_PER_PHASE
#define GRID_BAR() do { } while (0)
#else
    XcdBarrier bar = xcd_barrier_post((unsigned*)(args.ws + WS_CTL) + 1024, MISC + 8);
#define GRID_BAR() xcd_barrier(bar)
#endif
    const int lo = args.ph_lo, hi = args.ph_hi;
#define IN(k) (lo <= (k) && (k) < hi)
#define SEAM(k) do { if (IN(k) && IN((k) + 1)) GRID_BAR(); } while (0)

    if (IN(0)) { PHASE_IDS(); const Args a = fresh_args(); p0_prologue(a, lds, gw, NGW, lane, wave); }
    SEAM(0);
    for (int l = 0; l < DEPTH; ++l) {
        const int p = 1 + 4 * l;
        if (IN(p)) {
            const Args a = fresh_args();
            pg8::Gemm g{(const bf16*)(a.ws + WS_XB), (const bf16*)(a.ws + WS_WT1) + (size_t)l * NIN * DM, MPAD, NIN, DM};
            pg8::StaticOrder S; S.init(MPAD, NIN, G, bx);
            EpiProj E{a.ws};
            pg8::gemm_phase<EpiProj, pg8::StaticOrder, true, true>(lds + RING_OFF, g, S, E);
        }
        SEAM(p);
        if (IN(p + 1)) {
            PHASE_IDS(); const Args a = fresh_args();
            for (int it = bx; it < BATCH * NH * 4; it += G) kvscan_item(a, l, it, lds, tid);
            for (int it = gw; it < DECB * NH; it += NGW) sample_ret_item(a, l, it, lane);
            for (int it = gw; it < DECB; it += NGW) sample_gm_item(a, l, it, lane);
        }
        SEAM(p + 1);
        if (IN(p + 2)) {
            PHASE_IDS(); const Args a = fresh_args();
            for (int it = bx; it < BATCH * NCH * NH; it += G) ret_item(a, l, it, lds, tid);
            for (int it = bx; it < BATCH * NCH * NH; it += G) gm_item(a, l, it, lds, tid);
            __syncthreads();
        }
        SEAM(p + 2);
        if (IN(p + 3)) {
            const Args a = fresh_args();
            pg8::Gemm g{(const bf16*)(a.ws + WS_CAT), (const bf16*)(a.ws + WS_WT2) + (size_t)l * DM * MIXW, MPAD, DM, MIXW};
            pg8::StaticOrder S; S.init(MPAD, DM, G, bx);
            EpiRes E{l == 0 ? a.in[0] : (const float*)(a.ws + WS_H32), l == 0 ? a.in[1] : (const float*)(a.ws + WS_H32) + (size_t)MP * DM,
                     l == 0 ? (float*)(a.ws + WS_H32) : a.out + OUT_Y, a.ws};
            pg8::gemm_phase<EpiRes, pg8::StaticOrder, true, true>(lds + RING_OFF, g, S, E);
        }
        SEAM(p + 3);
    }
    if (IN(9)) {
        PHASE_IDS(); const Args a = fresh_args();
        for (int m = gw; m < MT; m += NGW) {
            const float* rp = (const float*)(a.ws + WS_RS) + (size_t)m * 16; float ssq = 0.f;
#pragma unroll
            for (int i = 0; i < 16; ++i) ssq += rp[i];
            const float rr = rsqrtf(ssq * (1.0f / 1024.0f) + EPS);
            f32x4* yr = (f32x4*)(a.out + OUT_Y + (size_t)m * DM) + lane; const f32x4* fg = (const f32x4*)a.in[10] + lane;
#pragma unroll
            for (int j = 0; j < 4; ++j) yr[64 * j] = yr[64 * j] * rr * fg[64 * j];
        }
    }
#undef IN
#undef SEAM
}

extern "C" void kernel_launch(void* const* d_in, const int* in_sizes, int n_in, void* d_out, int out_size, void* d_ws, size_t ws_size, hipStream_t stream) {
    static int grid = 0;
    if (grid == 0) {
        int dev = 0, cus = 0;
        if (n_in != 11 || ws_size < WS_END) { fprintf(stderr, "kernel_launch: unexpected n_in %d / ws_size %zu\n", n_in, ws_size); grid = -1; return; }
        if (hipGetDevice(&dev) != hipSuccess || hipDeviceGetAttribute(&cus, hipDeviceAttributeMultiprocessorCount, dev) != hipSuccess) { grid = -1; return; }
        if (hipFuncSetAttribute((const void*)fwd_kernel, hipFuncAttributeMaxDynamicSharedMemorySize, LDS_BYTES) != hipSuccess) { grid = -1; return; }
        (void)hipGetLastError();
        grid = cus;
    }
    if (grid < 0) return;
    (void)hipMemsetAsync((char*)d_ws + WS_CTL, 0, CTL_ZERO_BYTES, stream);
    Args a{};
    for (int i = 0; i < 11; ++i) a.in[i] = (const float*)d_in[i];
    a.out = (float*)d_out; a.ws = (unsigned char*)d_ws;
#if MK_PER_PHASE
    for (int p = 0; p < NPHASE; ++p) { a.ph_lo = p; a.ph_hi = p + 1; hipLaunchKernelGGL(fwd_kernel, dim3(grid), dim3(NTHR), LDS_BYTES, stream, a); }
#else
    a.ph_lo = 0; a.ph_hi = NPHASE; hipLaunchKernelGGL(fwd_kernel, dim3(grid), dim3(NTHR), LDS_BYTES, stream, a);
#endif
}
```

```cpp
#include <hip/hip_runtime.h>
#include <cstdio>
#include <cstdint>

#ifndef MK_PER_PHASE
#define MK_PER_PHASE 0
#endif

namespace pg8 {
#define PG8_LAS __attribute__((address_space(3)))
typedef unsigned short bf16_t;
typedef short bf16x8 __attribute__((ext_vector_type(8)));
typedef float f32x4 __attribute__((ext_vector_type(4)));
typedef unsigned u32x4 __attribute__((ext_vector_type(4)));
typedef unsigned u32x2 __attribute__((ext_vector_type(2)));
constexpr int BM = 256, BK = 64, HALF = 128, HTB = HALF * BK * 2  , STAGE_BYTES = 8 * HTB, NXCD = 8, WGM = 8;

__host__ __device__ __forceinline__ int lds_byte(int r, int c) { const int st = (r >> 4) * 2 + (c >> 5), rr = r & 15, cc = c & 31, ob = rr * 64 + cc * 2; return st * 1024 + (ob ^ (((ob >> 9) & 1) << 5)); }
__host__ __device__ __forceinline__ void stage_rc(int b, int& R, int& C) { const int st = b / 1024, sb = b % 1024, swz = sb ^ (((sb >> 9) & 1) << 5); R = (st >> 1) * 16 + swz / 64; C = (st & 1) * 32 + (swz % 64) / 2; }
__host__ __device__ __forceinline__ int perm32(int rho) { const int n = rho >> 4, i = rho & 15; return 8 * (i >> 2) + 4 * n + (i & 3); }

struct Unit { int pm, pn; };
struct Gemm { const bf16_t* A; const bf16_t* Bt; int M, N, K; };

struct StaticOrder {
    int nM, nN, nwg, G, c;
    __host__ __device__ void init(int M, int N, int G_, int c_) { nM = M / BM; nN = N / BM; nwg = nM * nN; G = G_; c = c_; }
    __host__ __device__ bool next(int i, Unit& u) const {
        const long L = (long)i * G + c; if (L >= nwg) return false;
        int wgid = (int)L; { const int q = nwg / NXCD, r = nwg % NXCD, xcd = wgid % NXCD, off = wgid / NXCD; wgid = (xcd < r ? xcd * (q + 1) : r * (q + 1) + (xcd - r) * q) + off; }
        const int nig = WGM * nN, gid = wgid / nig, fm = gid * WGM, gsz = (nM - fm) < WGM ? (nM - fm) : WGM;
        u.pm = fm + ((wgid % nig) % gsz); u.pn = (wgid % nig) / gsz; return true;
    }
    __device__ __forceinline__ void a_ready(const Unit&) const {}
    __device__ __forceinline__ void done(const Unit&) const {}
};

__device__ __forceinline__ unsigned cvt_pk_bf16(float lo, float hi) { unsigned r; asm volatile("v_cvt_pk_bf16_f32 %0, %1, %2" : "=v"(r) : "v"(lo), "v"(hi)); return r; }

template <class Epi, class Sched, bool ALIGN_EPI = false, bool SP2 = false>
__device__ __forceinline__ void gemm_phase(PG8_LAS unsigned char* lds, const Gemm g, const Sched& S, const Epi& E) {
    int tid_ = threadIdx.x; asm volatile("" : "+v"(tid_));
    const int tid = tid_, wid = __builtin_amdgcn_readfirstlane(tid >> 6), lane = tid & 63, wr = wid >> 2, wc = wid & 3, fr = lane & 15, fq = lane >> 4;
    const int K = g.K, nt = K / BK;
    unsigned voffA[2], voffB[2];
#pragma unroll
    for (int i = 0; i < 2; ++i) { int R, C; stage_rc(tid * 16 + i * 8192, R, C); const int Rb = Epi::PERM ? ((R & ~31) + perm32(R & 31)) : R;
        voffA[i] = (unsigned)(R * K + C) * 2u; voffB[i] = (unsigned)(Rb * K + C) * 2u; }
    const size_t kstep = (size_t)(BK * 2);
    const size_t hstep = (size_t)HALF * K * 2;
    const size_t tstep = 2 * hstep;
    const unsigned ldsw = (unsigned)wid * 1024u;
    const int aoff = lds_byte(wr * 64 + fr, fq * 8), boff = lds_byte(wc * 32 + fr, fq * 8);
#define PG8_SA(b, h) (((b) * 2 + (h)) * HTB)
#define PG8_SB(b, h) ((4 + (b) * 2 + (h)) * HTB)
#define PG8_STAGE(bufoff, gbase, voff) do { _Pragma("unroll") for (int _i = 0; _i < 2; ++_i) \
        __builtin_amdgcn_global_load_lds((const unsigned*)((const char*)(gbase) + (voff)[_i]), (PG8_LAS unsigned*)(lds + (bufoff) + ldsw + _i * 8192), 16, 0, 0); } while (0)
#define PG8_LDA(dst, b, h) do { _Pragma("unroll") for (int m = 0; m < 4; ++m) _Pragma("unroll") for (int k = 0; k < 2; ++k) dst[m][k] = *(const PG8_LAS bf16x8*)(lds + PG8_SA(b, h) + aoff + m * 2048 + k * 1024); } while (0)
#define PG8_LDB(dst, b, h) do { _Pragma("unroll") for (int n = 0; n < 2; ++n) _Pragma("unroll") for (int k = 0; k < 2; ++k) dst[n][k] = *(const PG8_LAS bf16x8*)(lds + PG8_SB(b, h) + boff + n * 2048 + k * 1024); } while (0)
#define PG8_MMA(ai, bj, At, Bt) do { __builtin_amdgcn_s_setprio(1); _Pragma("unroll") for (int m = 0; m < 4; ++m) _Pragma("unroll") for (int n = 0; n < 2; ++n) _Pragma("unroll") for (int k = 0; k < 2; ++k) \
        acc[ai][bj][m][n] = __builtin_amdgcn_mfma_f32_16x16x32_bf16(Bt[n][k], At[m][k], acc[ai][bj][m][n], 0, 0, 0); __builtin_amdgcn_s_setprio(0); } while (0)
#define PG8_WAIT_V(n) asm volatile("s_waitcnt vmcnt(" #n ")" ::: "memory")
#define PG8_WAIT_L(n) asm volatile("s_waitcnt lgkmcnt(" #n ")" ::: "memory")
#define PG8_BAR __builtin_amdgcn_s_barrier()
#define PG8_SCHED __builtin_amdgcn_sched_barrier(0)
    Unit cur, nxt; int ui = 0;
    if (!S.next(0, cur)) return;
    f32x4 acc[2][2][4][2];
#pragma unroll
    for (int a = 0; a < 2; ++a)
#pragma unroll
        for (int b = 0; b < 2; ++b)
#pragma unroll
            for (int m = 0; m < 4; ++m)
#pragma unroll
                for (int n = 0; n < 2; ++n) acc[a][b][m][n] = (f32x4){0.f, 0.f, 0.f, 0.f};
    bf16x8 At[4][2], B0[2][2], B1[2][2];
    const char* cA = (const char*)g.A + (size_t)cur.pm * tstep; const char* cB = (const char*)g.Bt + (size_t)cur.pn * tstep;
    S.a_ready(cur);
    if constexpr (SP2) {
        PG8_STAGE(PG8_SB(0, 0), cB, voffB); PG8_STAGE(PG8_SB(0, 1), cB + hstep, voffB); PG8_STAGE(PG8_SA(0, 0), cA, voffA); PG8_STAGE(PG8_SA(0, 1), cA + hstep, voffA);
        if (wr == 1) PG8_BAR;
        PG8_WAIT_V(2); PG8_BAR;
        PG8_STAGE(PG8_SB(1, 0), cB + kstep, voffB); PG8_STAGE(PG8_SA(1, 0), cA + kstep, voffA); PG8_STAGE(PG8_SB(1, 1), cB + hstep + kstep, voffB);
        PG8_WAIT_V(6); PG8_BAR;
    } else {
        PG8_STAGE(PG8_SB(0, 0), cB, voffB); PG8_STAGE(PG8_SA(0, 0), cA, voffA); PG8_STAGE(PG8_SB(0, 1), cB + hstep, voffB); PG8_STAGE(PG8_SA(0, 1), cA + hstep, voffA);
        if (wr == 1) PG8_BAR;
        PG8_WAIT_V(4); PG8_BAR;
        PG8_STAGE(PG8_SB(1, 0), cB + kstep, voffB); PG8_STAGE(PG8_SA(1, 0), cA + kstep, voffA); PG8_STAGE(PG8_SB(1, 1), cB + hstep + kstep, voffB);
        PG8_WAIT_V(6); PG8_BAR;
    }
    for (;;) {
        const bool has_next = S.next(ui + 1, nxt);
        const char* nA = has_next ? (const char*)g.A + (size_t)nxt.pm * tstep : cA; const char* nB = has_next ? (const char*)g.Bt + (size_t)nxt.pn * tstep : cB;
        for (int t = 0; t < nt; t += 2) {
            const bool last = (t == nt - 2);
            const char* a1 = cA + (size_t)(t + 1) * kstep;
            const char* a2 = last ? nA : cA + (size_t)(t + 2) * kstep; const char* b2 = last ? nB : cB + (size_t)(t + 2) * kstep;
            const char* a3 = a2 + kstep; const char* b3 = b2 + kstep;
            if (last && has_next) S.a_ready(nxt);
            if constexpr (SP2) {
            PG8_LDB(B0, 0, 0); PG8_LDB(B1, 0, 1); PG8_SCHED; PG8_LDA(At, 0, 0); PG8_STAGE(PG8_SA(1, 1), a1 + hstep, voffA);
            PG8_WAIT_V(8); PG8_WAIT_L(0); PG8_BAR; PG8_MMA(0, 0, At, B0); PG8_MMA(0, 1, At, B1); PG8_BAR; PG8_SCHED;
            PG8_LDA(At, 0, 1); PG8_STAGE(PG8_SB(0, 0), b2, voffB); PG8_STAGE(PG8_SB(0, 1), b2 + hstep, voffB); PG8_STAGE(PG8_SA(0, 0), a2, voffA);
            PG8_WAIT_V(8); PG8_WAIT_L(0); PG8_BAR; PG8_MMA(1, 0, At, B0); PG8_MMA(1, 1, At, B1); PG8_BAR; PG8_SCHED;
            PG8_LDB(B0, 1, 0); PG8_LDB(B1, 1, 1); PG8_SCHED; PG8_LDA(At, 1, 0); PG8_STAGE(PG8_SA(0, 1), a2 + hstep, voffA);
            PG8_WAIT_V(8); PG8_WAIT_L(0); PG8_BAR; PG8_MMA(0, 0, At, B0); PG8_MMA(0, 1, At, B1); PG8_BAR; PG8_SCHED;
            PG8_LDA(At, 1, 1); PG8_STAGE(PG8_SB(1, 0), b3, voffB); PG8_STAGE(PG8_SB(1, 1), b3 + hstep, voffB); PG8_STAGE(PG8_SA(1, 0), a3, voffA);
            PG8_WAIT_V(8); PG8_WAIT_L(0); PG8_BAR; PG8_MMA(1, 0, At, B0); PG8_MMA(1, 1, At, B1); PG8_BAR; PG8_SCHED;
            } else {
            PG8_LDB(B0, 0, 0); PG8_SCHED; PG8_LDA(At, 0, 0); PG8_STAGE(PG8_SA(1, 1), a1 + hstep, voffA);
            PG8_WAIT_L(8); PG8_BAR; PG8_WAIT_L(0); PG8_MMA(0, 0, At, B0); PG8_BAR; PG8_SCHED;
            PG8_LDB(B1, 0, 1); PG8_STAGE(PG8_SB(0, 0), b2, voffB);
            PG8_BAR; PG8_WAIT_L(0); PG8_MMA(0, 1, At, B1); PG8_BAR;
            PG8_LDA(At, 0, 1); PG8_STAGE(PG8_SA(0, 0), a2, voffA);
            PG8_BAR; PG8_WAIT_L(0); PG8_MMA(1, 0, At, B0); PG8_BAR; PG8_SCHED;
            PG8_STAGE(PG8_SB(0, 1), b2 + hstep, voffB);
            PG8_WAIT_V(6); PG8_BAR; PG8_MMA(1, 1, At, B1); PG8_BAR;
            PG8_LDB(B0, 1, 0); PG8_SCHED; PG8_LDA(At, 1, 0); PG8_STAGE(PG8_SA(0, 1), a2 + hstep, voffA);
            PG8_WAIT_L(8); PG8_BAR; PG8_WAIT_L(0); PG8_MMA(0, 0, At, B0); PG8_BAR; PG8_SCHED;
            PG8_LDB(B1, 1, 1); PG8_STAGE(PG8_SB(1, 0), b3, voffB);
            PG8_BAR; PG8_WAIT_L(0); PG8_MMA(0, 1, At, B1); PG8_BAR;
            PG8_LDA(At, 1, 1); PG8_STAGE(PG8_SA(1, 0), a3, voffA);
            PG8_BAR; PG8_WAIT_L(0); PG8_MMA(1, 0, At, B0); PG8_BAR; PG8_SCHED;
            PG8_STAGE(PG8_SB(1, 1), b3 + hstep, voffB);
            PG8_WAIT_V(6); PG8_BAR; PG8_MMA(1, 1, At, B1); PG8_BAR;
            }
        }
        if constexpr (ALIGN_EPI) { if (wr == 0) PG8_BAR; }
        E(acc, cur, wr, wc, fr, fq); S.done(cur);
        if (!has_next) break;
#pragma unroll
        for (int a = 0; a < 2; ++a)
#pragma unroll
            for (int b = 0; b < 2; ++b)
#pragma unroll
                for (int m = 0; m < 4; ++m)
#pragma unroll
                    for (int n = 0; n < 2; ++n) acc[a][b][m][n] = (f32x4){0.f, 0.f, 0.f, 0.f};
        cur = nxt; cA = nA; cB = nB; ++ui;
        if constexpr (ALIGN_EPI) { if (wr == 1) PG8_BAR; }
    }
    PG8_WAIT_V(0);
    if constexpr (!ALIGN_EPI) { if (wr == 0) PG8_BAR; }
    PG8_BAR;
#undef PG8_SA
#undef PG8_SB
#undef PG8_STAGE
#undef PG8_LDA
#undef PG8_LDB
#undef PG8_MMA
#undef PG8_WAIT_V
#undef PG8_WAIT_L
#undef PG8_BAR
#undef PG8_SCHED
}
}

constexpr int NWAVES = 8, NTHR = NWAVES * 64;
constexpr int DM = 1024, BATCH = 8, SEQ = 2048, DEPTH = 2, DECB = 128, PAST = 16384;
constexpr int MP = BATCH * SEQ;
constexpr int MT = MP + DECB;
constexpr int MPAD = 16640;
constexpr int NIN = 7168, MIXW = 2048, CH = 128, NH = 8, HD = 128, NCH = SEQ / CH;
constexpr float EPS = 1e-6f;

constexpr size_t MiB = 1u << 20;
constexpr size_t WS_CTL = 0, CTL_ZERO_BYTES = 64 * 1024;
constexpr size_t WS_WT1 = 1 * MiB;
constexpr size_t WS_WT2 = 29 * MiB;
constexpr size_t WS_WG  = 37 * MiB;
constexpr size_t WS_ROPE = 37 * MiB + 512 * 1024;
constexpr size_t WS_RS  = 39 * MiB;
constexpr size_t WS_LNS = 41 * MiB;
constexpr size_t WS_XB  = 44 * MiB;
constexpr size_t WS_H32 = 77 * MiB;
constexpr size_t PROJ_BYTES = (size_t)MPAD * 1024 * 2;
constexpr size_t WS_Q   = 142 * MiB;
constexpr size_t WS_K   = WS_Q + PROJ_BYTES;
constexpr size_t WS_V   = WS_K + PROJ_BYTES;
constexpr size_t WS_SGR = WS_V + PROJ_BYTES;
constexpr size_t WS_UG  = WS_SGR + PROJ_BYTES;
constexpr size_t WS_VG  = WS_UG + PROJ_BYTES;
constexpr size_t WS_CAT = 337 * MiB;
constexpr size_t WS_ST  = 402 * MiB;
constexpr size_t WS_END = 434 * MiB;
static_assert(WS_VG + PROJ_BYTES <= WS_CAT && WS_H32 + (size_t)MT * 1024 * 4 <= WS_Q && WS_XB + PROJ_BYTES <= WS_H32, "ws map");

constexpr size_t OUT_Y   = 0;
constexpr size_t OUT_SP  = (size_t)MT * 1024;
constexpr size_t OUT_SS  = OUT_SP + (size_t)DEPTH * BATCH * NH * HD * HD;
constexpr size_t OUT_GV  = OUT_SS + (size_t)DEPTH * DECB * NH * HD * HD;

constexpr int RING_OFF = 0, RING_BYTES = 131072;
constexpr int LDS_BYTES = 147456;
constexpr int MISC_OFF = LDS_BYTES - 512;

#define GAS __attribute__((address_space(1)))
#define LAS __attribute__((address_space(3)))
typedef unsigned short bf16;
typedef unsigned v4u __attribute__((ext_vector_type(4)));
typedef unsigned v2u __attribute__((ext_vector_type(2)));
typedef float f32x4 __attribute__((ext_vector_type(4)));
typedef float f32x2 __attribute__((ext_vector_type(2)));
#define LDS_WAIT() asm volatile("s_waitcnt lgkmcnt(0)" ::: "memory")
__device__ __forceinline__ unsigned f2bf(float f) { unsigned u = __builtin_bit_cast(unsigned, f); return (u + 0x7fffu + ((u >> 16) & 1u)) >> 16; }
__device__ __forceinline__ unsigned pk2(float lo, float hi) { return f2bf(lo) | (f2bf(hi) << 16); }
__device__ __forceinline__ float bf2f(unsigned b) { return __builtin_bit_cast(float, b << 16); }
__device__ __forceinline__ float bflo(unsigned w) { return __builtin_bit_cast(float, w << 16); }
__device__ __forceinline__ float bfhi(unsigned w) { return __builtin_bit_cast(float, w & 0xffff0000u); }
__device__ __forceinline__ float silu_f(float x) { return x / (1.0f + __expf(-x)); }
__device__ __forceinline__ float wave_sum(float v) {
#pragma unroll
    for (int o = 1; o < 64; o <<= 1) v += __shfl_xor(v, o);
    return v;
}
__device__ __forceinline__ float lg2gamma(int h) {
    return h == 0 ? -0.04580368961312479f : h == 1 ? -0.02272007650008353f : h == 2 ? -0.011315313227834146f : h == 3 ? -0.005646563141142063f :
           h == 4 ? -0.0028205190623786626f : h == 5 ? -0.0014095702546713536f : h == 6 ? -0.0007046129765893727f : -0.0003522634716290214f;
}

#define XB_TMO      128
#define XB_XCNT(j)  (256  + 64 * (j))
#define XB_XSUB(j)  (1280 + 64 * (j))
#define XB_XGEN(j)  (2304 + 64 * (j))
#define XB_TOP      3328
#define XB_TOPGEN   3392
#define XCD_BAR_WORDS 3456
#define XB_SPIN_CAP (1u << 18)
__device__ __forceinline__ unsigned xb_ld(unsigned* p)              { return __hip_atomic_load(p, __ATOMIC_RELAXED, __HIP_MEMORY_SCOPE_AGENT); }
__device__ __forceinline__ unsigned xb_add(unsigned* p, unsigned v) { return __hip_atomic_fetch_add(p, v, __ATOMIC_RELAXED, __HIP_MEMORY_SCOPE_AGENT); }
__device__ __forceinline__ unsigned xb_xcc_id() { return (unsigned)__builtin_amdgcn_s_getreg((3 << 11) | 20) & 0xFu; }
#define XB_SPIN(cond, bar) do { unsigned _sp = 0; while (cond) { __builtin_amdgcn_s_sleep(1); \
    if ((++_sp & 255u) == 0u) { if (xb_ld(&(bar)[XB_TMO])) break; if (_sp > XB_SPIN_CAP) { atomicAdd(&(bar)[XB_TMO], 1u); break; } } } } while (0)
struct XcdBarrier { unsigned* bar; unsigned x; volatile LAS unsigned* st; };
__device__ __forceinline__ XcdBarrier xcd_barrier_post(unsigned* bar, volatile LAS unsigned* st) {
    XcdBarrier b; b.bar = bar; b.x = xb_xcc_id(); b.st = st;
    if (threadIdx.x == 0) (void)xb_add(&bar[XB_XCNT(b.x)], 1u);
    return b;
}
__device__ __forceinline__ void xcd_barrier_complete(unsigned* bar, unsigned x, unsigned& nloc, unsigned& nx) {
    const unsigned G = gridDim.x * gridDim.y * gridDim.z;
    unsigned sum, cnt, mine, sp = 0u;
    for (;;) {
        sum = 0u; cnt = 0u; mine = 0u;
#pragma unroll
        for (unsigned j = 0; j < 16; ++j) { const unsigned c = xb_ld(&bar[XB_XCNT(j)]); sum += c; cnt += (c > 0u) ? 1u : 0u; mine = (j == x) ? c : mine; }
        if (sum == G) break;
        __builtin_amdgcn_s_sleep(1);
        if ((++sp & 255u) == 0u) { if (xb_ld(&bar[XB_TMO])) break; if (sp > XB_SPIN_CAP) { atomicAdd(&bar[XB_TMO], 1u); break; } }
    }
    nloc = mine > 0u ? mine : 1u; nx = cnt > 0u ? cnt : 1u;
}
__device__ __forceinline__ void xcd_barrier(const XcdBarrier& b) {
    asm volatile("s_waitcnt vmcnt(0)" ::: "memory");
    __syncthreads();
    if (threadIdx.x == 0) {
        unsigned* bar = b.bar;
        __builtin_amdgcn_s_waitcnt(0);
        unsigned nloc = b.st[0], nx = b.st[1];
        if (nloc == 0u) { xcd_barrier_complete(bar, b.x, nloc, nx); b.st[0] = nloc; b.st[1] = nx; }
        const unsigned old = xb_add(&bar[XB_XSUB(b.x)], 1u);
        const unsigned gen = old / nloc;
        if (old + 1u == (gen + 1u) * nloc) {
            __builtin_amdgcn_fence(__ATOMIC_RELEASE, "agent");
            asm volatile("s_waitcnt vmcnt(0)" ::: "memory");
            const unsigned og = xb_add(&bar[XB_TOP], 1u);
            const unsigned tg = og / nx;
            if (og + 1u == (tg + 1u) * nx) xb_add(&bar[XB_TOPGEN], 1u);
            else XB_SPIN(xb_ld(&bar[XB_TOPGEN]) == tg, bar);
            __builtin_amdgcn_fence(__ATOMIC_ACQUIRE, "agent");
            xb_add(&bar[XB_XGEN(b.x)], 1u);
            asm volatile("s_waitcnt vmcnt(0)" ::: "memory");
        } else {
            XB_SPIN(xb_ld(&bar[XB_XGEN(b.x)]) == gen, bar);
            __builtin_amdgcn_fence(__ATOMIC_ACQUIRE, "agent");
            asm volatile("s_waitcnt vmcnt(0)" ::: "memory");
        }
    }
    __syncthreads();
}

struct EpiProj {
    static constexpr bool PERM = true;
    unsigned char* ws;
    __device__ __forceinline__ void operator()(const pg8::f32x4 (&acc)[2][2][4][2], const pg8::Unit& u, int wr, int wc, int fr, int fq) const {
        bf16* const Q = (bf16*)(ws + WS_Q); bf16* const K = (bf16*)(ws + WS_K); bf16* const V = (bf16*)(ws + WS_V); bf16* const SGR = (bf16*)(ws + WS_SGR);
        bf16* const UG = (bf16*)(ws + WS_UG); bf16* const VG = (bf16*)(ws + WS_VG); const float* const RS = (const float*)(ws + WS_RS); float* const LNS = (float*)(ws + WS_LNS);
        const float* const rope = (const float*)(ws + WS_ROPE);
        const int pn = u.pn, rowb = u.pm * 256 + wr * 64 + fr;
#pragma unroll
        for (int ai = 0; ai < 2; ++ai)
#pragma unroll
            for (int m = 0; m < 4; ++m) {
                const int row = rowb + ai * 128 + m * 16;
                const f32x4* rp = (const f32x4*)(RS + (size_t)row * 16);
                const f32x4 r0 = rp[0], r1 = rp[1], r2 = rp[2], r3 = rp[3];
                const float ssq = ((r0.x + r0.y) + (r0.z + r0.w)) + ((r1.x + r1.y) + (r1.z + r1.w)) + ((r2.x + r2.y) + (r2.z + r2.w)) + ((r3.x + r3.y) + (r3.z + r3.w));
                const float rr = rsqrtf(ssq * (1.0f / 1024.0f) + EPS);
                if (pn < 8) {
                    const int head = 2 * (pn & 3) + (wc >> 1), f0 = 32 * (wc & 1) + 8 * fq;
                    const int pidx = row < MP ? (row & (SEQ - 1)) : SEQ;
                    const int ci = row < MP ? (row & (CH - 1)) : 0;
                    const float e = lg2gamma(head) * (float)(ci + 1);
                    const float sc = rr * (pn < 4 ? exp2f(e) : exp2f(-e) * 0.08838834764831845f);
                    const f32x4* cs = (const f32x4*)(rope + ((size_t)pidx * 64 + f0) * 2);
                    float o1[8], o2[8];
#pragma unroll
                    for (int t = 0; t < 4; ++t) { const f32x4 c4 = cs[t];
                        const int e0 = 2 * t, e1 = 2 * t + 1;
                        const float a0 = acc[ai][0][m][e0 >> 2][e0 & 3], b0 = acc[ai][1][m][e0 >> 2][e0 & 3];
                        const float a1 = acc[ai][0][m][e1 >> 2][e1 & 3], b1 = acc[ai][1][m][e1 >> 2][e1 & 3];
                        o1[e0] = (a0 * c4.x - b0 * c4.y) * sc; o2[e0] = (a0 * c4.y + b0 * c4.x) * sc;
                        o1[e1] = (a1 * c4.z - b1 * c4.w) * sc; o2[e1] = (a1 * c4.w + b1 * c4.z) * sc; }
                    bf16* dst = (pn < 4 ? Q : K) + (size_t)row * 1024 + 128 * head + f0;
                    pg8::u32x4 w1, w2;
                    w1.x = pg8::cvt_pk_bf16(o1[0], o1[1]); w1.y = pg8::cvt_pk_bf16(o1[2], o1[3]); w1.z = pg8::cvt_pk_bf16(o1[4], o1[5]); w1.w = pg8::cvt_pk_bf16(o1[6], o1[7]);
                    w2.x = pg8::cvt_pk_bf16(o2[0], o2[1]); w2.y = pg8::cvt_pk_bf16(o2[2], o2[3]); w2.z = pg8::cvt_pk_bf16(o2[4], o2[5]); w2.w = pg8::cvt_pk_bf16(o2[6], o2[7]);
                    *(pg8::u32x4*)dst = w1; *(pg8::u32x4*)(dst + 64) = w2;
                } else if (pn < 16) {
                    const bool isv = pn < 12;
                    bf16* dst = (isv ? V : SGR) + (size_t)row * 1024 + 256 * (isv ? pn - 8 : pn - 12) + 32 * wc + 8 * fq;
#pragma unroll
                    for (int bj = 0; bj < 2; ++bj) { f32x4 v0 = acc[ai][bj][m][0] * rr, v1 = acc[ai][bj][m][1] * rr;
                        if (!isv) {
#pragma unroll
                            for (int j = 0; j < 4; ++j) { v0[j] = silu_f(v0[j]); v1[j] = silu_f(v1[j]); } }
                        pg8::u32x4 w; w.x = pg8::cvt_pk_bf16(v0[0], v0[1]); w.y = pg8::cvt_pk_bf16(v0[2], v0[3]); w.z = pg8::cvt_pk_bf16(v1[0], v1[1]); w.w = pg8::cvt_pk_bf16(v1[2], v1[3]);
                        *(pg8::u32x4*)(dst + 128 * bj) = w; }
                } else if (pn < 24) {
                    bf16* dst = UG + (size_t)row * 1024 + 128 * (pn - 16) + 32 * wc + 8 * fq;
                    f32x4 v0 = acc[ai][0][m][0] * rr, v1 = acc[ai][0][m][1] * rr; const f32x4 g0 = acc[ai][1][m][0] * rr, g1 = acc[ai][1][m][1] * rr;
#pragma unroll
                    for (int j = 0; j < 4; ++j) { v0[j] *= silu_f(g0[j]); v1[j] *= silu_f(g1[j]); }
                    pg8::u32x4 w; w.x = pg8::cvt_pk_bf16(v0[0], v0[1]); w.y = pg8::cvt_pk_bf16(v0[2], v0[3]); w.z = pg8::cvt_pk_bf16(v1[0], v1[1]); w.w = pg8::cvt_pk_bf16(v1[2], v1[3]);
                    *(pg8::u32x4*)dst = w;
                } else {
                    bf16* dst = VG + (size_t)row * 1024 + 256 * (pn - 24) + 32 * wc + 8 * fq;
                    float s1 = 0.f, s2 = 0.f;
#pragma unroll
                    for (int bj = 0; bj < 2; ++bj) { const f32x4 v0 = acc[ai][bj][m][0] * rr, v1 = acc[ai][bj][m][1] * rr;
#pragma unroll
                        for (int j = 0; j < 4; ++j) { s1 += v0[j] + v1[j]; s2 += v0[j] * v0[j] + v1[j] * v1[j]; }
                        pg8::u32x4 w; w.x = pg8::cvt_pk_bf16(v0[0], v0[1]); w.y = pg8::cvt_pk_bf16(v0[2], v0[3]); w.z = pg8::cvt_pk_bf16(v1[0], v1[1]); w.w = pg8::cvt_pk_bf16(v1[2], v1[3]);
                        *(pg8::u32x4*)(dst + 128 * bj) = w; }
                    s1 += __shfl_xor(s1, 16); s1 += __shfl_xor(s1, 32); s2 += __shfl_xor(s2, 16); s2 += __shfl_xor(s2, 32);
                    if (fq == 0) *(f32x2*)(LNS + ((size_t)row * 16 + (pn - 24) * 4 + wc) * 2) = (f32x2){s1, s2};
                }
            }
    }
};
struct EpiRes {
    static constexpr bool PERM = false;
    const float* res_p; const float* res_s; float* out; unsigned char* ws;
    __device__ __forceinline__ void operator()(const pg8::f32x4 (&acc)[2][2][4][2], const pg8::Unit& u, int wr, int wc, int fr, int fq) const {
        bf16* const XB = (bf16*)(ws + WS_XB); float* const RS = (float*)(ws + WS_RS);
        const int rowb = u.pm * 256 + wr * 64 + fr, colb = u.pn * 256 + wc * 32 + 4 * fq;
#pragma unroll
        for (int ai = 0; ai < 2; ++ai)
#pragma unroll
            for (int m = 0; m < 4; ++m) {
                const int row = rowb + ai * 128 + m * 16; const bool ok = row < MT;
                float ssq = 0.f;
                if (ok) {
                    const float* rsrc = (row < MP ? res_p + (size_t)row * 1024 : res_s + (size_t)(row - MP) * 1024) + colb;
                    float* o = out + (size_t)row * 1024 + colb; bf16* xb = XB + (size_t)row * 1024 + colb;
#pragma unroll
                    for (int bj = 0; bj < 2; ++bj)
#pragma unroll
                        for (int n = 0; n < 2; ++n) { const f32x4 hn = *(const f32x4*)(rsrc + bj * 128 + n * 16) + acc[ai][bj][m][n];
                            *(f32x4*)(o + bj * 128 + n * 16) = hn; ssq += (hn.x * hn.x + hn.y * hn.y) + (hn.z * hn.z + hn.w * hn.w);
                            pg8::u32x2 w; w.x = pg8::cvt_pk_bf16(hn.x, hn.y); w.y = pg8::cvt_pk_bf16(hn.z, hn.w); *(pg8::u32x2*)(xb + bj * 128 + n * 16) = w; }
                }
                ssq += __shfl_xor(ssq, 16); ssq += __shfl_xor(ssq, 32);
                if (ok && fq == 0) RS[(size_t)row * 16 + u.pn * 4 + wc] = ssq;
            }
    }
};

struct Args { const float* in[11]; float* out; unsigned char* ws; int ph_lo, ph_hi; };

#define CAS __attribute__((address_space(4)))
__device__ __forceinline__ Args fresh_args() { const unsigned long long p0 = (unsigned long long)__builtin_amdgcn_kernarg_segment_ptr();
    unsigned plo = __builtin_amdgcn_readfirstlane((unsigned)p0), phi = __builtin_amdgcn_readfirstlane((unsigned)(p0 >> 32)); asm volatile("" : "+s"(plo), "+s"(phi));
    const CAS Args* q = (const CAS Args*)(((unsigned long long)phi << 32) | plo); Args r;
#pragma unroll
    for (int i = 0; i < 11; ++i) r.in[i] = q->in[i];
    r.out = q->out; r.ws = q->ws; r.ph_lo = q->ph_lo; r.ph_hi = q->ph_hi; return r; }
__device__ __forceinline__ int colmap(int np) {
    const int pn = np >> 8, tc = np & 255;
    if (pn < 8) { const int base = (pn < 4) ? 0 : 1024, head = 2 * (pn & 3) + ((tc & 127) >> 6), part = tc >> 7; return base + 128 * head + 64 * part + (tc & 63); }
    if (pn < 12) return 2048 + 256 * (pn - 8) + tc;
    if (pn < 16) return 3072 + 256 * (pn - 12) + tc;
    if (pn < 24) { const int head = pn - 16; return tc < 128 ? 4096 + 128 * head + tc : 6144 + 128 * head + (tc - 128); }
    return 5120 + 256 * (pn - 24) + tc;
}
__device__ __forceinline__ void p0_transpose_item(const float* W, int K, int N, bf16* WT, const float* gk, int k0, int src_n0, int dst_n0, LAS float* scr, int lane) {
#pragma unroll 8
    for (int i = 0; i < 32; ++i) { const int kk = 2 * i + (lane >> 5); float v = W[(size_t)(k0 + kk) * N + src_n0 + (lane & 31)]; if (gk) v *= gk[k0 + kk]; scr[kk * 33 + (lane & 31)] = v; }
    LDS_WAIT(); asm volatile("" ::: "memory");
    const int c = lane & 7;
#pragma unroll
    for (int j = 0; j < 4; ++j) { const int n = (lane >> 3) + 8 * j; const LAS float* s = scr + (8 * c) * 33 + n;
        v4u o; o.x = pk2(s[0 * 33], s[1 * 33]); o.y = pk2(s[2 * 33], s[3 * 33]); o.z = pk2(s[4 * 33], s[5 * 33]); o.w = pk2(s[6 * 33], s[7 * 33]);
        *(v4u*)(WT + (size_t)(dst_n0 + n) * K + k0 + 8 * c) = o; }
    LDS_WAIT(); asm volatile("" ::: "memory");
}
__device__ __forceinline__ void p0_prologue(const Args& a, LAS unsigned char* lds, int gw, int NGW, int lane, int wave) {
    LAS float* scr = (LAS float*)(lds + RING_OFF + wave * 16384);
    unsigned char* ws = a.ws;
    constexpr int I1 = (DM / 64) * (NIN / 32), I2 = (MIXW / 64) * (DM / 32), NITEMS = DEPTH * (I1 + I2);
    for (int it = gw; it < NITEMS; it += NGW) {
        const int l = it / (I1 + I2); int r = it % (I1 + I2);
        if (r < I1) { const int kb = r / (NIN / 32), nb = r % (NIN / 32);
            p0_transpose_item(a.in[4] + (size_t)l * DM * NIN, DM, NIN, (bf16*)(ws + WS_WT1) + (size_t)l * NIN * DM, a.in[3] + l * DM, 64 * kb, colmap(32 * nb), 32 * nb, scr, lane); }
        else { r -= I1; const int kb = r / (DM / 32), nb = r % (DM / 32);
            p0_transpose_item(a.in[5] + (size_t)l * MIXW * DM, MIXW, DM, (bf16*)(ws + WS_WT2) + (size_t)l * DM * MIXW, nullptr, 64 * kb, 32 * nb, 32 * nb, scr, lane); }
    }
    for (int m = gw; m < MT; m += NGW) {
        const float* xrow = m < MP ? a.in[0] + (size_t)m * DM : a.in[1] + (size_t)(m - MP) * DM;
        const f32x4* xr = (const f32x4*)xrow + lane; f32x4 v[4]; float s = 0.f;
#pragma unroll
        for (int j = 0; j < 4; ++j) { v[j] = xr[64 * j]; s += (v[j].x * v[j].x + v[j].y * v[j].y) + (v[j].z * v[j].z + v[j].w * v[j].w); }
        s = wave_sum(s);
        unsigned long long* o8 = (unsigned long long*)((bf16*)(ws + WS_XB) + (size_t)m * DM) + lane;
#pragma unroll
        for (int j = 0; j < 4; ++j) o8[64 * j] = (unsigned long long)pk2(v[j].x, v[j].y) | ((unsigned long long)pk2(v[j].z, v[j].w) << 32);
        if (lane < 16) ((float*)(ws + WS_RS))[(size_t)m * 16 + lane] = lane == 0 ? s : 0.f;
    }
    const int gt = gw * 64 + lane, NGT = NGW * 64;
    for (int i = gt; i < (SEQ + 1) * 64; i += NGT) {
        const int pidx = i >> 6, f = i & 63; const double pos = pidx < SEQ ? (double)pidx : (double)PAST;
        double inv = 1.0; for (int j = 0; j < f; ++j) inv *= 0.8659643233600653;
        const double ang = pos * inv; const double q = __builtin_rint(ang * 0.63661977236758134308);
        double r = __builtin_fma(-q, 1.5707963267948966, ang); r = __builtin_fma(-q, 6.123233995736766e-17, r);
        const double r2 = r * r;
        const double sn = r * (1.0 + r2 * (-1.0 / 6 + r2 * (1.0 / 120 + r2 * (-1.0 / 5040 + r2 * (1.0 / 362880 + r2 * (-1.0 / 39916800 + r2 * (1.0 / 6227020800.0)))))));
        const double cs = 1.0 + r2 * (-0.5 + r2 * (1.0 / 24 + r2 * (-1.0 / 720 + r2 * (1.0 / 40320 + r2 * (-1.0 / 3628800 + r2 * (1.0 / 479001600.0))))));
        const int qi = ((int)q) & 3;
        const double c = qi == 0 ? cs : qi == 1 ? -sn : qi == 2 ? -cs : sn;
        const double s = qi == 0 ? sn : qi == 1 ? cs : qi == 2 ? -sn : -cs;
        ((f32x2*)(ws + WS_ROPE))[i] = (f32x2){(float)c, (float)s};
    }
    for (int i = gt; i < DEPTH * NH * CH * CH; i += NGT) { const int jj = i & 127, ii = (i >> 7) & 127; ((bf16*)(ws + WS_WG))[i] = jj <= ii ? (bf16)f2bf(a.in[6][i]) : (bf16)0; }
}

constexpr int LP = 136;
constexpr int TILE_B = 128 * LP * 2;
__device__ __forceinline__ void load_tile_bf16(LAS bf16* dst, const bf16* src, int ld, int tid) {
#pragma unroll
    for (int i = 0; i < 4; ++i) { const int ch = tid + i * NTHR, r = ch >> 4, c = (ch & 15) * 8; *(LAS v4u*)(dst + r * LP + c) = *(const v4u*)(src + (size_t)r * ld + c); }
}
__device__ __forceinline__ void kvscan_item(const Args& a, int l, int item, LAS unsigned char* lds, int tid) {
    const int b = item >> 5, h = (item >> 2) & 7, dq = item & 3;
    LAS bf16* Ks = (LAS bf16*)lds; LAS bf16* Vs = (LAS bf16*)(lds + TILE_B);
    const bf16* Kg = (const bf16*)(a.ws + WS_K); const bf16* Vg = (const bf16*)(a.ws + WS_V); bf16* ST = (bf16*)(a.ws + WS_ST);
    const int dvl = tid & 31, dkg = tid >> 5, dv = dq * 32 + dvl;
    float S[8];
#pragma unroll
    for (int e = 0; e < 8; ++e) S[e] = 0.f;
    const float g128 = exp2f(lg2gamma(h) * 128.0f);
    for (int c = 0; c < NCH; ++c) {
        const size_t row0 = (size_t)b * SEQ + c * CH;
        { v4u w; w.x = pk2(S[0], S[1]); w.y = pk2(S[2], S[3]); w.z = pk2(S[4], S[5]); w.w = pk2(S[6], S[7]);
          *(v4u*)(ST + ((((size_t)b * NCH + c) * NH + h) * HD + dv) * HD + dkg * 8) = w; }
        __syncthreads();
        load_tile_bf16(Ks, Kg + row0 * 1024 + 128 * h, 1024, tid);
        load_tile_bf16(Vs, Vg + row0 * 1024 + 128 * h, 1024, tid);
        __syncthreads();
        for (int j = 0; j < CH; ++j) {
            const v4u kk = *(const LAS v4u*)(Ks + j * LP + dkg * 8); const float vv = bf2f(Vs[j * LP + dv]);
            S[0] += bflo(kk.x) * vv; S[1] += bfhi(kk.x) * vv; S[2] += bflo(kk.y) * vv; S[3] += bfhi(kk.y) * vv;
            S[4] += bflo(kk.z) * vv; S[5] += bfhi(kk.z) * vv; S[6] += bflo(kk.w) * vv; S[7] += bfhi(kk.w) * vv;
        }
#pragma unroll
        for (int e = 0; e < 8; ++e) S[e] *= g128;
    }
    float* so = a.out + OUT_SP + ((((size_t)l * BATCH + b) * NH + h) * HD) * HD;
#pragma unroll
    for (int e = 0; e < 8; ++e) so[(size_t)(dkg * 8 + e) * HD + dv] = S[e];
    __syncthreads();
}
__device__ __forceinline__ void sample_ret_item(const Args& a, int l, int item, int lane) {
    const int b = item >> 3, h = item & 7; const size_t row = (size_t)MP + b;
    const bf16* Qg = (const bf16*)(a.ws + WS_Q) + row * 1024 + 128 * h; const bf16* Kg = (const bf16*)(a.ws + WS_K) + row * 1024 + 128 * h;
    const bf16* Vg = (const bf16*)(a.ws + WS_V) + row * 1024 + 128 * h; const bf16* Gg = (const bf16*)(a.ws + WS_SGR) + row * 1024 + 128 * h;
    const float* S0 = a.in[2] + ((((size_t)l * DECB + b) * NH + h) * HD) * HD; float* S1 = a.out + OUT_SS + ((((size_t)l * DECB + b) * NH + h) * HD) * HD;
    const int c4 = lane & 31, r2 = lane >> 5; const float gam = exp2f(lg2gamma(h));
    const v2u vw = *(const v2u*)(Vg + 4 * c4); const float v0 = bflo(vw.x), v1 = bfhi(vw.x), v2 = bflo(vw.y), v3 = bfhi(vw.y);
    f32x4 o = {0.f, 0.f, 0.f, 0.f};
#pragma unroll 8
    for (int t = 0; t < 64; ++t) {
        const int d = 2 * t + r2; const float qd = bf2f(Qg[d]), kd = bf2f(Kg[d]);
        const f32x4 s0 = *(const f32x4*)(S0 + (size_t)d * HD + 4 * c4);
        f32x4 t1; t1.x = s0.x + kd * v0; t1.y = s0.y + kd * v1; t1.z = s0.z + kd * v2; t1.w = s0.w + kd * v3;
        o += t1 * qd; *(f32x4*)(S1 + (size_t)d * HD + 4 * c4) = t1 * gam;
    }
    o.x += __shfl_xor(o.x, 32); o.y += __shfl_xor(o.y, 32); o.z += __shfl_xor(o.z, 32); o.w += __shfl_xor(o.w, 32);
    float ss = (o.x * o.x + o.y * o.y) + (o.z * o.z + o.w * o.w);
#pragma unroll
    for (int s = 1; s < 32; s <<= 1) ss += __shfl_xor(ss, s);
    const float rs = rsqrtf(ss * (1.0f / 128.0f) + EPS);
    const v2u gw = *(const v2u*)(Gg + 4 * c4);
    if (r2 == 0) { v2u w; w.x = pk2(o.x * rs * bflo(gw.x), o.y * rs * bfhi(gw.x)); w.y = pk2(o.z * rs * bflo(gw.y), o.w * rs * bfhi(gw.y));
        *(v2u*)((bf16*)(a.ws + WS_CAT) + row * 2048 + 128 * h + 4 * c4) = w; }
}
__device__ __forceinline__ void sample_gm_item(const Args& a, int l, int b, int lane) {
    const size_t row = (size_t)MP + b;
    const float* lp = (const float*)(a.ws + WS_LNS) + row * 32; float s1 = 0.f, s2 = 0.f;
#pragma unroll
    for (int i = 0; i < 16; ++i) { s1 += lp[2 * i]; s2 += lp[2 * i + 1]; }
    const float mu = s1 * (1.0f / 1024.0f), var = s2 * (1.0f / 1024.0f) - mu * mu, rstd = rsqrtf(var + EPS);
    const bf16* vg = (const bf16*)(a.ws + WS_VG) + row * 1024; const bf16* ug = (const bf16*)(a.ws + WS_UG) + row * 1024;
    float* gv = a.out + OUT_GV + ((size_t)l * DECB + b) * 1024; bf16* cat = (bf16*)(a.ws + WS_CAT) + row * 2048 + 1024;
#pragma unroll
    for (int j = 0; j < 4; ++j) { const int c = 4 * lane + 256 * j, h = c >> 7;
        const v2u vw = *(const v2u*)(vg + c), uw = *(const v2u*)(ug + c);
        const f32x4 lg = *(const f32x4*)(a.in[8] + l * 1024 + c), lb = *(const f32x4*)(a.in[9] + l * 1024 + c);
        f32x4 vn; vn.x = (bflo(vw.x) - mu) * rstd * lg.x + lb.x; vn.y = (bfhi(vw.x) - mu) * rstd * lg.y + lb.y; vn.z = (bflo(vw.y) - mu) * rstd * lg.z + lb.z; vn.w = (bfhi(vw.y) - mu) * rstd * lg.w + lb.w;
        *(f32x4*)(gv + c) = vn;
        const float w00 = a.in[6][((size_t)l * NH + h) * CH * CH], b0 = a.in[7][((size_t)l * NH + h) * CH];
        v2u w; w.x = pk2((w00 * vn.x + b0) * bflo(uw.x), (w00 * vn.y + b0) * bfhi(uw.x)); w.y = pk2((w00 * vn.z + b0) * bflo(uw.y), (w00 * vn.w + b0) * bfhi(uw.y));
        *(v2u*)(cat + c) = w; }
}
__device__ __forceinline__ void ret_item(const Args& a, int l, int item, LAS unsigned char* lds, int tid) {
    const int b = item >> 7, c = (item >> 3) & 15, h = item & 7; const size_t row0 = (size_t)b * SEQ + c * CH;
    LAS bf16* Qs = (LAS bf16*)lds; LAS bf16* Ks = (LAS bf16*)(lds + TILE_B); LAS bf16* SC = (LAS bf16*)(lds + 2 * TILE_B); LAS bf16* Ss = (LAS bf16*)(lds + 3 * TILE_B);
    __syncthreads();
    load_tile_bf16(Qs, (const bf16*)(a.ws + WS_Q) + row0 * 1024 + 128 * h, 1024, tid);
    load_tile_bf16(Ks, (const bf16*)(a.ws + WS_K) + row0 * 1024 + 128 * h, 1024, tid);
    { const bf16* ST = (const bf16*)(a.ws + WS_ST) + ((((size_t)b * NCH + c) * NH + h) * HD) * HD;
#pragma unroll
      for (int i = 0; i < 4; ++i) { const int ch = tid + i * NTHR, dv = ch >> 4, dk0 = (ch & 15) * 8; const v4u w = *(const v4u*)(ST + (size_t)dv * HD + dk0);
          Ss[(dk0 + 0) * LP + dv] = (bf16)(w.x & 0xffff); Ss[(dk0 + 1) * LP + dv] = (bf16)(w.x >> 16); Ss[(dk0 + 2) * LP + dv] = (bf16)(w.y & 0xffff); Ss[(dk0 + 3) * LP + dv] = (bf16)(w.y >> 16);
          Ss[(dk0 + 4) * LP + dv] = (bf16)(w.z & 0xffff); Ss[(dk0 + 5) * LP + dv] = (bf16)(w.z >> 16); Ss[(dk0 + 6) * LP + dv] = (bf16)(w.w & 0xffff); Ss[(dk0 + 7) * LP + dv] = (bf16)(w.w >> 16); } }
    __syncthreads();
    const int i = tid >> 2, jq = tid & 3;
    for (int jj = 0; jj < 32; ++jj) { const int j = 32 * jq + jj; float s = 0.f;
        if (j <= i) {
#pragma unroll 4
            for (int d8 = 0; d8 < 16; ++d8) { const v4u qa = *(const LAS v4u*)(Qs + i * LP + 8 * d8), kb = *(const LAS v4u*)(Ks + j * LP + 8 * d8);
                s += bflo(qa.x) * bflo(kb.x) + bfhi(qa.x) * bfhi(kb.x) + bflo(qa.y) * bflo(kb.y) + bfhi(qa.y) * bfhi(kb.y)
                   + bflo(qa.z) * bflo(kb.z) + bfhi(qa.z) * bfhi(kb.z) + bflo(qa.w) * bflo(kb.w) + bfhi(qa.w) * bfhi(kb.w); } }
        SC[i * LP + j] = (bf16)f2bf(s); }
    __syncthreads();
    load_tile_bf16(Ks, (const bf16*)(a.ws + WS_V) + row0 * 1024 + 128 * h, 1024, tid);
    __syncthreads();
    float o[32];
#pragma unroll
    for (int e = 0; e < 32; ++e) o[e] = 0.f;
    const int dq = jq;
    for (int j = 0; j <= i; ++j) { const float s = bf2f(SC[i * LP + j]);
#pragma unroll
        for (int g = 0; g < 4; ++g) { const v4u vv = *(const LAS v4u*)(Ks + j * LP + 32 * dq + 8 * g);
            o[8 * g + 0] += s * bflo(vv.x); o[8 * g + 1] += s * bfhi(vv.x); o[8 * g + 2] += s * bflo(vv.y); o[8 * g + 3] += s * bfhi(vv.y);
            o[8 * g + 4] += s * bflo(vv.z); o[8 * g + 5] += s * bfhi(vv.z); o[8 * g + 6] += s * bflo(vv.w); o[8 * g + 7] += s * bfhi(vv.w); } }
    for (int d = 0; d < HD; ++d) { const float s = bf2f(Qs[i * LP + d]);
#pragma unroll
        for (int g = 0; g < 4; ++g) { const v4u vv = *(const LAS v4u*)(Ss + d * LP + 32 * dq + 8 * g);
            o[8 * g + 0] += s * bflo(vv.x); o[8 * g + 1] += s * bfhi(vv.x); o[8 * g + 2] += s * bflo(vv.y); o[8 * g + 3] += s * bfhi(vv.y);
            o[8 * g + 4] += s * bflo(vv.z); o[8 * g + 5] += s * bfhi(vv.z); o[8 * g + 6] += s * bflo(vv.w); o[8 * g + 7] += s * bfhi(vv.w); } }
    float ss = 0.f;
#pragma unroll
    for (int e = 0; e < 32; ++e) ss += o[e] * o[e];
    ss += __shfl_xor(ss, 1); ss += __shfl_xor(ss, 2);
    const float rs = rsqrtf(ss * (1.0f / 128.0f) + EPS);
    const bf16* Gg = (const bf16*)(a.ws + WS_SGR) + (row0 + i) * 1024 + 128 * h + 32 * dq; bf16* cat = (bf16*)(a.ws + WS_CAT) + (row0 + i) * 2048 + 128 * h + 32 * dq;
#pragma unroll
    for (int g = 0; g < 4; ++g) { const v4u gg = *(const v4u*)(Gg + 8 * g); v4u w;
        w.x = pk2(o[8 * g + 0] * rs * bflo(gg.x), o[8 * g + 1] * rs * bfhi(gg.x)); w.y = pk2(o[8 * g + 2] * rs * bflo(gg.y), o[8 * g + 3] * rs * bfhi(gg.y));
        w.z = pk2(o[8 * g + 4] * rs * bflo(gg.z), o[8 * g + 5] * rs * bfhi(gg.z)); w.w = pk2(o[8 * g + 6] * rs * bflo(gg.w), o[8 * g + 7] * rs * bfhi(gg.w));
        *(v4u*)(cat + 8 * g) = w; }
}
__device__ __forceinline__ void gm_item(const Args& a, int l, int item, LAS unsigned char* lds, int tid) {
    const int b = item >> 7, c = (item >> 3) & 15, h = item & 7; const size_t row0 = (size_t)b * SEQ + c * CH;
    LAS bf16* VN = (LAS bf16*)lds; LAS bf16* WG = (LAS bf16*)(lds + TILE_B); LAS float* ST2 = (LAS float*)(lds + 2 * TILE_B);
    __syncthreads();
    if (tid < 128) { const float* lp = (const float*)(a.ws + WS_LNS) + (row0 + tid) * 32; float s1 = 0.f, s2 = 0.f;
#pragma unroll
        for (int i = 0; i < 16; ++i) { s1 += lp[2 * i]; s2 += lp[2 * i + 1]; }
        const float mu = s1 * (1.0f / 1024.0f), var = s2 * (1.0f / 1024.0f) - mu * mu; ST2[2 * tid] = mu; ST2[2 * tid + 1] = rsqrtf(var + EPS); }
    load_tile_bf16(WG, (const bf16*)(a.ws + WS_WG) + ((size_t)l * NH + h) * CH * CH, 128, tid);
    __syncthreads();
    { const bf16* vg = (const bf16*)(a.ws + WS_VG) + row0 * 1024 + 128 * h; const float* lg = a.in[8] + l * 1024 + 128 * h; const float* lb = a.in[9] + l * 1024 + 128 * h;
#pragma unroll
      for (int i = 0; i < 4; ++i) { const int ch = tid + i * NTHR, r = ch >> 4, c0 = (ch & 15) * 8; const v4u w = *(const v4u*)(vg + (size_t)r * 1024 + c0);
          const float mu = ST2[2 * r], rstd = ST2[2 * r + 1]; const f32x4 g0 = *(const f32x4*)(lg + c0), g1 = *(const f32x4*)(lg + c0 + 4), b0 = *(const f32x4*)(lb + c0), b1 = *(const f32x4*)(lb + c0 + 4);
          v4u o; o.x = pk2((bflo(w.x) - mu) * rstd * g0.x + b0.x, (bfhi(w.x) - mu) * rstd * g0.y + b0.y); o.y = pk2((bflo(w.y) - mu) * rstd * g0.z + b0.z, (bfhi(w.y) - mu) * rstd * g0.w + b0.w);
          o.z = pk2((bflo(w.z) - mu) * rstd * g1.x + b1.x, (bfhi(w.z) - mu) * rstd * g1.y + b1.y); o.w = pk2((bflo(w.w) - mu) * rstd * g1.z + b1.z, (bfhi(w.w) - mu) * rstd * g1.w + b1.w);
          *(LAS v4u*)(VN + r * LP + c0) = o; } }
    __syncthreads();
    const int i = tid >> 2, dq = tid & 3;
    float o[32]; const float bi = a.in[7][((size_t)l * NH + h) * CH + i];
#pragma unroll
    for (int e = 0; e < 32; ++e) o[e] = bi;
    for (int j = 0; j <= i; ++j) { const float s = bf2f(WG[i * LP + j]);
#pragma unroll
        for (int g = 0; g < 4; ++g) { const v4u vv = *(const LAS v4u*)(VN + j * LP + 32 * dq + 8 * g);
            o[8 * g + 0] += s * bflo(vv.x); o[8 * g + 1] += s * bfhi(vv.x); o[8 * g + 2] += s * bflo(vv.y); o[8 * g + 3] += s * bfhi(vv.y);
            o[8 * g + 4] += s * bflo(vv.z); o[8 * g + 5] += s * bfhi(vv.z); o[8 * g + 6] += s * bflo(vv.w); o[8 * g + 7] += s * bfhi(vv.w); } }
    const bf16* Ug = (const bf16*)(a.ws + WS_UG) + (row0 + i) * 1024 + 128 * h + 32 * dq; bf16* cat = (bf16*)(a.ws + WS_CAT) + (row0 + i) * 2048 + 1024 + 128 * h + 32 * dq;
#pragma unroll
    for (int g = 0; g < 4; ++g) { const v4u gg = *(const v4u*)(Ug + 8 * g); v4u w;
        w.x = pk2(o[8 * g + 0] * bflo(gg.x), o[8 * g + 1] * bfhi(gg.x)); w.y = pk2(o[8 * g + 2] * bflo(gg.y), o[8 * g + 3] * bfhi(gg.y));
        w.z = pk2(o[8 * g + 4] * bflo(gg.z), o[8 * g + 5] * bfhi(gg.z)); w.w = pk2(o[8 * g + 6] * bflo(gg.w), o[8 * g + 7] * bfhi(gg.w));
        *(v4u*)(cat + 8 * g) = w; }
}

typedef short s16x4 __attribute__((ext_vector_type(4)));
typedef short bf16x8 __attribute__((ext_vector_type(8)));
typedef float f32x16 __attribute__((ext_vector_type(16)));
typedef __bf16 bf16x2v __attribute__((ext_vector_type(2)));
#define MFMA32(a, b, c) __builtin_amdgcn_mfma_f32_32x32x16_bf16((a), (b), (c), 0, 0, 0)
__device__ __forceinline__ unsigned pkbf(float lo, float hi) { const bf16x2v r = __builtin_convertvector((f32x2){lo, hi}, bf16x2v); return __builtin_bit_cast(unsigned, r); }
__device__ __forceinline__ unsigned offb(unsigned row, unsigned ch) { return 256u * row + 16u * (ch ^ (((row & 3u) << 2) | ((row >> 2) & 3u))); }
__device__ __forceinline__ bf16x8 rowfrag(LAS unsigned char* tile, int R0, int lane, int s) { return *(const LAS bf16x8*)(tile + offb(R0 + (lane & 31), 2 * s + (lane >> 5))); }
template <bool PERMK> __device__ __forceinline__ bf16x8 trfrag(LAS unsigned char* tile, int R0, int lane, int c, int ks) {
    const int hh = lane >> 5, blk = (lane >> 4) & 1, q = (lane & 15) >> 2, p = lane & 3;
    const int r0 = R0 + 16 * ks + (PERMK ? 4 * hh : 8 * hh) + q, r1 = r0 + (PERMK ? 8 : 4), ch = 4 * c + 2 * blk + (p >> 1);
    const s16x4 lo = __builtin_amdgcn_ds_read_tr16_b64_v4i16((LAS s16x4*)(tile + offb(r0, ch) + 8 * (p & 1)));
    const s16x4 hi = __builtin_amdgcn_ds_read_tr16_b64_v4i16((LAS s16x4*)(tile + offb(r1, ch) + 8 * (p & 1)));
    return __builtin_shufflevector(lo, hi, 0, 1, 2, 3, 4, 5, 6, 7);
}
__device__ __forceinline__ bf16x8 trfrag64(LAS unsigned char* tile, int lane, int ks) {
    const int hh = lane >> 5, blk = (lane >> 4) & 1, q = (lane & 15) >> 2, p = lane & 3;
    const int r0 = 16 * ks + 8 * hh + q; const int cb = (2 * blk + (p >> 1)) * 16 + 8 * (p & 1);
    const s16x4 lo = __builtin_amdgcn_ds_read_tr16_b64_v4i16((LAS s16x4*)(tile + r0 * 64 + cb));
    const s16x4 hi = __builtin_amdgcn_ds_read_tr16_b64_v4i16((LAS s16x4*)(tile + (r0 + 4) * 64 + cb));
    return __builtin_shufflevector(lo, hi, 0, 1, 2, 3, 4, 5, 6, 7);
}
__device__ __forceinline__ bf16x8 packx(const f32x16& x, int s) {
    v4u p; p.x = pkbf(x[8 * s + 0], x[8 * s + 1]); p.y = pkbf(x[8 * s + 2], x[8 * s + 3]); p.z = pkbf(x[8 * s + 4], x[8 * s + 5]); p.w = pkbf(x[8 * s + 6], x[8 * s + 7]);
    return __builtin_bit_cast(bf16x8, p);
}
__device__ __forceinline__ void stage_tile(LAS unsigned char* tile, const bf16* src, int ld, int tid) {
    v4u w[4];
#pragma unroll
    for (int i = 0; i < 4; ++i) { const int ch = tid + i * NTHR; w[i] = *(const v4u*)(src + (size_t)(ch >> 4) * ld + (ch & 15) * 8); }
#pragma unroll
    for (int i = 0; i < 4; ++i) { const int ch = tid + i * NTHR; *(LAS v4u*)(tile + offb(ch >> 4, ch & 15)) = w[i]; }
}
constexpr int T32K = 32768;

__device__ __forceinline__ void kvscan_item_mfma(const Args& a, int l, int item, LAS unsigned char* lds, int tid) {
    const int b = item >> 5, hd = (item >> 2) & 7, dq = item & 3, lane = tid & 63, w = __builtin_amdgcn_readfirstlane(tid >> 6), hh = lane >> 5, cl = lane & 31;
    LAS unsigned char* Kt = lds; LAS unsigned char* Vt = lds + T32K;
    const bf16* Kg = (const bf16*)(a.ws + WS_K); const bf16* Vg = (const bf16*)(a.ws + WS_V); bf16* ST = (bf16*)(a.ws + WS_ST);
    f32x16 S;
#pragma unroll
    for (int i = 0; i < 16; ++i) S[i] = 0.f;
    const float g128 = exp2f(lg2gamma(hd) * 128.0f);
    for (int c = 0; c < NCH; ++c) {
        const size_t row0 = (size_t)b * SEQ + c * CH;
        if (w < 4) { bf16* st = ST + ((((size_t)b * NCH + c) * NH + hd) * HD + 32 * dq + cl) * HD + 32 * w + 4 * hh;
#pragma unroll
            for (int g = 0; g < 4; ++g) { v2u o; o.x = pkbf(S[4 * g], S[4 * g + 1]); o.y = pkbf(S[4 * g + 2], S[4 * g + 3]); *(v2u*)(st + 8 * g) = o; } }
        __syncthreads();
        stage_tile(Kt, Kg + row0 * 1024 + 128 * hd, 1024, tid);
        { const int r = tid >> 2, ch = tid & 3; *(LAS v4u*)(Vt + r * 64 + ch * 16) = *(const v4u*)(Vg + (row0 + r) * 1024 + 128 * hd + 32 * dq + ch * 8); }
        __syncthreads();
        if (w < 4) {
#pragma unroll
            for (int ks = 0; ks < 8; ++ks) { const bf16x8 A = trfrag<false>(Kt, 0, lane, w, ks); const bf16x8 B = trfrag64(Vt, lane, ks); S = MFMA32(A, B, S); }
#pragma unroll
            for (int i = 0; i < 16; ++i) S[i] *= g128;
        }
    }
    if (w < 4) { float* so = a.out + OUT_SP + ((((size_t)l * BATCH + b) * NH + hd) * HD) * HD + 32 * dq + cl;
#pragma unroll
        for (int i = 0; i < 16; ++i) so[(size_t)(32 * w + (i & 3) + 8 * (i >> 2) + 4 * hh) * HD] = S[i]; }
    __syncthreads();
}
__device__ __forceinline__ void ret_item_mfma(const Args& a, int l, int item, LAS unsigned char* lds, int tid) {
    const int b = item >> 7, c = (item >> 3) & 15, hd = item & 7, lane = tid & 63, w = __builtin_amdgcn_readfirstlane(tid >> 6), hh = lane >> 5, cl = lane & 31, ib = w & 3, dh = w >> 2;
    const size_t row0 = (size_t)b * SEQ + c * CH;
    LAS unsigned char* Qt = lds; LAS unsigned char* Kt = lds + T32K; LAS unsigned char* Vt = lds + 2 * T32K; LAS unsigned char* St = lds + 3 * T32K; LAS float* red = (LAS float*)(lds + 4 * T32K);
    __syncthreads();
    stage_tile(Qt, (const bf16*)(a.ws + WS_Q) + row0 * 1024 + 128 * hd, 1024, tid);
    stage_tile(Kt, (const bf16*)(a.ws + WS_K) + row0 * 1024 + 128 * hd, 1024, tid);
    stage_tile(Vt, (const bf16*)(a.ws + WS_V) + row0 * 1024 + 128 * hd, 1024, tid);
    stage_tile(St, (const bf16*)(a.ws + WS_ST) + ((((size_t)b * NCH + c) * NH + hd) * HD) * HD, 128, tid);
    __syncthreads();
    bf16x8 qf[8];
#pragma unroll
    for (int s = 0; s < 8; ++s) qf[s] = rowfrag(Qt, 32 * ib, lane, s);
    f32x16 o0, o1;
#pragma unroll
    for (int i = 0; i < 16; ++i) { o0[i] = 0.f; o1[i] = 0.f; }
    for (int jb = 0; jb <= ib; ++jb) {
        f32x16 X;
#pragma unroll
        for (int i = 0; i < 16; ++i) X[i] = 0.f;
#pragma unroll
        for (int s = 0; s < 8; ++s) X = MFMA32(rowfrag(Kt, 32 * jb, lane, s), qf[s], X);
        if (jb == ib) {
#pragma unroll
            for (int i = 0; i < 16; ++i) { const int jl = (i & 3) + 8 * (i >> 2) + 4 * hh; X[i] = jl <= cl ? X[i] : 0.f; }
        }
#pragma unroll
        for (int s2 = 0; s2 < 2; ++s2) { const bf16x8 xb = packx(X, s2);
            o0 = MFMA32(trfrag<true>(Vt, 32 * jb, lane, 2 * dh + 0, s2), xb, o0);
            o1 = MFMA32(trfrag<true>(Vt, 32 * jb, lane, 2 * dh + 1, s2), xb, o1); }
    }
#pragma unroll
    for (int s = 0; s < 8; ++s) { o0 = MFMA32(rowfrag(St, 32 * (2 * dh + 0), lane, s), qf[s], o0); o1 = MFMA32(rowfrag(St, 32 * (2 * dh + 1), lane, s), qf[s], o1); }
    float ssq = 0.f;
#pragma unroll
    for (int i = 0; i < 16; ++i) ssq += o0[i] * o0[i] + o1[i] * o1[i];
    ssq += __shfl_xor(ssq, 32);
    if (lane < 32) red[w * 32 + lane] = ssq;
    __syncthreads();
    const float rs = rsqrtf((red[ib * 32 + cl] + red[(ib + 4) * 32 + cl]) * (1.0f / 128.0f) + EPS);
    const size_t row = row0 + 32 * ib + cl;
    const bf16* Gg = (const bf16*)(a.ws + WS_SGR) + row * 1024 + 128 * hd + 64 * dh + 4 * hh; bf16* cat = (bf16*)(a.ws + WS_CAT) + row * 2048 + 128 * hd + 64 * dh + 4 * hh;
#pragma unroll
    for (int g = 0; g < 4; ++g) {
        const v2u g0 = *(const v2u*)(Gg + 8 * g), g1 = *(const v2u*)(Gg + 32 + 8 * g); v2u w0, w1;
        w0.x = pkbf(o0[4 * g] * rs * bflo(g0.x), o0[4 * g + 1] * rs * bfhi(g0.x)); w0.y = pkbf(o0[4 * g + 2] * rs * bflo(g0.y), o0[4 * g + 3] * rs * bfhi(g0.y));
        w1.x = pkbf(o1[4 * g] * rs * bflo(g1.x), o1[4 * g + 1] * rs * bfhi(g1.x)); w1.y = pkbf(o1[4 * g + 2] * rs * bflo(g1.y), o1[4 * g + 3] * rs * bfhi(g1.y));
        *(v2u*)(cat + 8 * g) = w0; *(v2u*)(cat + 32 + 8 * g) = w1; }
}
__device__ __forceinline__ void gm_item_mfma(const Args& a, int l, int item, LAS unsigned char* lds, int tid) {
    const int b = item >> 7, c = (item >> 3) & 15, hd = item & 7, lane = tid & 63, w = __builtin_amdgcn_readfirstlane(tid >> 6), hh = lane >> 5, cl = lane & 31, ib = w & 3, gh = w >> 2;
    const size_t row0 = (size_t)b * SEQ + c * CH;
    LAS unsigned char* VNt = lds; LAS unsigned char* Wt = lds + T32K; LAS float* ST2 = (LAS float*)(lds + 2 * T32K);
    __syncthreads();
    if (tid < 128) { const float* lp = (const float*)(a.ws + WS_LNS) + (row0 + tid) * 32; float s1 = 0.f, s2 = 0.f;
#pragma unroll
        for (int i = 0; i < 16; ++i) { s1 += lp[2 * i]; s2 += lp[2 * i + 1]; }
        const float mu = s1 * (1.0f / 1024.0f), var = s2 * (1.0f / 1024.0f) - mu * mu; ST2[2 * tid] = mu; ST2[2 * tid + 1] = rsqrtf(var + EPS); }
    stage_tile(Wt, (const bf16*)(a.ws + WS_WG) + ((size_t)l * NH + hd) * CH * CH, 128, tid);
    __syncthreads();
    { const bf16* vg = (const bf16*)(a.ws + WS_VG) + row0 * 1024 + 128 * hd; const float* lg = a.in[8] + l * 1024 + 128 * hd; const float* lb = a.in[9] + l * 1024 + 128 * hd;
#pragma unroll
      for (int i = 0; i < 4; ++i) { const int ch = tid + i * NTHR, r = ch >> 4, c0 = (ch & 15) * 8; const v4u x = *(const v4u*)(vg + (size_t)r * 1024 + c0);
          const float mu = ST2[2 * r], rstd = ST2[2 * r + 1]; const f32x4 g0 = *(const f32x4*)(lg + c0), g1 = *(const f32x4*)(lg + c0 + 4), b0 = *(const f32x4*)(lb + c0), b1 = *(const f32x4*)(lb + c0 + 4);
          v4u o; o.x = pkbf((bflo(x.x) - mu) * rstd * g0.x + b0.x, (bfhi(x.x) - mu) * rstd * g0.y + b0.y); o.y = pkbf((bflo(x.y) - mu) * rstd * g0.z + b0.z, (bfhi(x.y) - mu) * rstd * g0.w + b0.w);
          o.z = pkbf((bflo(x.z) - mu) * rstd * g1.x + b1.x, (bfhi(x.z) - mu) * rstd * g1.y + b1.y); o.w = pkbf((bflo(x.w) - mu) * rstd * g1.z + b1.z, (bfhi(x.w) - mu) * rstd * g1.w + b1.w);
          *(LAS v4u*)(VNt + offb(r, ch & 15)) = o; } }
    __syncthreads();
    f32x16 s0, s1;
#pragma unroll
    for (int i = 0; i < 16; ++i) { s0[i] = 0.f; s1[i] = 0.f; }
    for (int ks = 0; ks < 2 * (ib + 1); ++ks) { const bf16x8 B = rowfrag(Wt, 32 * ib, lane, ks);
        s0 = MFMA32(trfrag<false>(VNt, 0, lane, 2 * gh + 0, ks), B, s0); s1 = MFMA32(trfrag<false>(VNt, 0, lane, 2 * gh + 1, ks), B, s1); }
    const float bi = a.in[7][((size_t)l * NH + hd) * CH + 32 * ib + cl];
    const size_t row = row0 + 32 * ib + cl;
    const bf16* Ug = (const bf16*)(a.ws + WS_UG) + row * 1024 + 128 * hd + 64 * gh + 4 * hh; bf16* cat = (bf16*)(a.ws + WS_CAT) + row * 2048 + 1024 + 128 * hd + 64 * gh + 4 * hh;
#pragma unroll
    for (int g = 0; g < 4; ++g) {
        const v2u g0 = *(const v2u*)(Ug + 8 * g), g1 = *(const v2u*)(Ug + 32 + 8 * g); v2u w0, w1;
        w0.x = pkbf((s0[4 * g] + bi) * bflo(g0.x), (s0[4 * g + 1] + bi) * bfhi(g0.x)); w0.y = pkbf((s0[4 * g + 2] + bi) * bflo(g0.y), (s0[4 * g + 3] + bi) * bfhi(g0.y));
        w1.x = pkbf((s1[4 * g] + bi) * bflo(g1.x), (s1[4 * g + 1] + bi) * bfhi(g1.x)); w1.y = pkbf((s1[4 * g + 2] + bi) * bflo(g1.y), (s1[4 * g + 3] + bi) * bfhi(g1.y));
        *(v2u*)(cat + 8 * g) = w0; *(v2u*)(cat + 32 + 8 * g) = w1; }
}

constexpr int NPHASE = 10;
__global__ void __launch_bounds__(NTHR, 2) fwd_kernel(Args args) {
    extern __shared__ __attribute__((aligned(16))) unsigned char lds_raw[];
    LAS unsigned char* lds = (LAS unsigned char*)lds_raw;
    volatile LAS unsigned* MISC = (volatile LAS unsigned*)(lds + MISC_OFF);
    const int G = gridDim.x, bx = blockIdx.x, NGW = G * NWAVES;
    if (threadIdx.x < 128) MISC[threadIdx.x] = 0u;
#define PHASE_IDS() int tid = threadIdx.x; asm volatile("" : "+v"(tid)); const int lane = tid & 63, wave = __builtin_amdgcn_readfirstlane(tid >> 6), gw = bx * NWAVES + wave; (void)lane; (void)gw
    __syncthreads();
#if MK_PER_PHASE
#define GRID_BAR() do { } while (0)
#else
    XcdBarrier bar = xcd_barrier_post((unsigned*)(args.ws + WS_CTL) + 1024, MISC + 8);
#define GRID_BAR() xcd_barrier(bar)
#endif
    const int lo = args.ph_lo, hi = args.ph_hi;
#define IN(k) (lo <= (k) && (k) < hi)
#define SEAM(k) do { if (IN(k) && IN((k) + 1)) GRID_BAR(); } while (0)

    if (IN(0)) { PHASE_IDS(); const Args a = fresh_args(); p0_prologue(a, lds, gw, NGW, lane, wave); }
    SEAM(0);
    for (int l = 0; l < DEPTH; ++l) {
        const int p = 1 + 4 * l;
        if (IN(p)) {
            const Args a = fresh_args();
            pg8::Gemm g{(const bf16*)(a.ws + WS_XB), (const bf16*)(a.ws + WS_WT1) + (size_t)l * NIN * DM, MPAD, NIN, DM};
            pg8::StaticOrder S; S.init(MPAD, NIN, G, bx);
            EpiProj E{a.ws};
            pg8::gemm_phase<EpiProj, pg8::StaticOrder, true, true>(lds + RING_OFF, g, S, E);
        }
        SEAM(p);
        if (IN(p + 1)) {
            PHASE_IDS(); const Args a = fresh_args();
            for (int it = bx; it < BATCH * NH * 4; it += G) kvscan_item_mfma(a, l, it, lds, tid);
            for (int it = gw; it < DECB * NH; it += NGW) sample_ret_item(a, l, it, lane);
            for (int it = gw; it < DECB; it += NGW) sample_gm_item(a, l, it, lane);
        }
        SEAM(p + 1);
        if (IN(p + 2)) {
            PHASE_IDS(); const Args a = fresh_args();
            for (int it = bx; it < BATCH * NCH * NH; it += G) ret_item_mfma(a, l, it, lds, tid);
            for (int it = bx; it < BATCH * NCH * NH; it += G) gm_item_mfma(a, l, it, lds, tid);
            __syncthreads();
        }
        SEAM(p + 2);
        if (IN(p + 3)) {
            const Args a = fresh_args();
            pg8::Gemm g{(const bf16*)(a.ws + WS_CAT), (const bf16*)(a.ws + WS_WT2) + (size_t)l * DM * MIXW, MPAD, DM, MIXW};
            pg8::StaticOrder S; S.init(MPAD, DM, G, bx);
            EpiRes E{l == 0 ? a.in[0] : (const float*)(a.ws + WS_H32), l == 0 ? a.in[1] : (const float*)(a.ws + WS_H32) + (size_t)MP * DM,
                     l == 0 ? (float*)(a.ws + WS_H32) : a.out + OUT_Y, a.ws};
            pg8::gemm_phase<EpiRes, pg8::StaticOrder, true, true>(lds + RING_OFF, g, S, E);
        }
        SEAM(p + 3);
    }
    if (IN(9)) {
        PHASE_IDS(); const Args a = fresh_args();
        for (int m = gw; m < MT; m += NGW) {
            const float* rp = (const float*)(a.ws + WS_RS) + (size_t)m * 16; float ssq = 0.f;
#pragma unroll
            for (int i = 0; i < 16; ++i) ssq += rp[i];
            const float rr = rsqrtf(ssq * (1.0f / 1024.0f) + EPS);
            f32x4* yr = (f32x4*)(a.out + OUT_Y + (size_t)m * DM) + lane; const f32x4* fg = (const f32x4*)a.in[10] + lane;
#pragma unroll
            for (int j = 0; j < 4; ++j) yr[64 * j] = yr[64 * j] * rr * fg[64 * j];
        }
    }
#undef IN
#undef SEAM
}

extern "C" void kernel_launch(void* const* d_in, const int* in_sizes, int n_in, void* d_out, int out_size, void* d_ws, size_t ws_size, hipStream_t stream) {
    static int grid = 0;
    if (grid == 0) {
        int dev = 0, cus = 0;
        if (n_in != 11 || ws_size < WS_END) { fprintf(stderr, "kernel_launch: unexpected n_in %d / ws_size %zu\n", n_in, ws_size); grid = -1; return; }
        if (hipGetDevice(&dev) != hipSuccess || hipDeviceGetAttribute(&cus, hipDeviceAttributeMultiprocessorCount, dev) != hipSuccess) { grid = -1; return; }
        if (hipFuncSetAttribute((const void*)fwd_kernel, hipFuncAttributeMaxDynamicSharedMemorySize, LDS_BYTES) != hipSuccess) { grid = -1; return; }
        (void)hipGetLastError();
        grid = cus;
    }
    if (grid < 0) return;
    (void)hipMemsetAsync((char*)d_ws + WS_CTL, 0, CTL_ZERO_BYTES, stream);
    Args a{};
    for (int i = 0; i < 11; ++i) a.in[i] = (const float*)d_in[i];
    a.out = (float*)d_out; a.ws = (unsigned char*)d_ws;
#if MK_PER_PHASE
    for (int p = 0; p < NPHASE; ++p) { a.ph_lo = p; a.ph_hi = p + 1; hipLaunchKernelGGL(fwd_kernel, dim3(grid), dim3(NTHR), LDS_BYTES, stream, a); }
#else
    a.ph_lo = 0; a.ph_hi = NPHASE; hipLaunchKernelGGL(fwd_kernel, dim3(grid), dim3(NTHR), LDS_BYTES, stream, a);
#endif
}
```

```cpp
#include <hip/hip_runtime.h>
#include <cstdio>
#include <cstdint>

#ifndef MK_PER_PHASE
#define MK_PER_PHASE 0
#endif

namespace pg8 {
#define PG8_LAS __attribute__((address_space(3)))
typedef unsigned short bf16_t;
typedef short bf16x8 __attribute__((ext_vector_type(8)));
typedef float f32x4 __attribute__((ext_vector_type(4)));
typedef unsigned u32x4 __attribute__((ext_vector_type(4)));
typedef unsigned u32x2 __attribute__((ext_vector_type(2)));
constexpr int BM = 256, BK = 64, HALF = 128, HTB = HALF * BK * 2  , STAGE_BYTES = 8 * HTB, NXCD = 8, WGM = 8;

__host__ __device__ __forceinline__ int lds_byte(int r, int c) { const int st = (r >> 4) * 2 + (c >> 5), rr = r & 15, cc = c & 31, ob = rr * 64 + cc * 2; return st * 1024 + (ob ^ (((ob >> 9) & 1) << 5)); }
__host__ __device__ __forceinline__ void stage_rc(int b, int& R, int& C) { const int st = b / 1024, sb = b % 1024, swz = sb ^ (((sb >> 9) & 1) << 5); R = (st >> 1) * 16 + swz / 64; C = (st & 1) * 32 + (swz % 64) / 2; }
__host__ __device__ __forceinline__ int perm32(int rho) { const int n = rho >> 4, i = rho & 15; return 8 * (i >> 2) + 4 * n + (i & 3); }

struct Unit { int pm, pn; };
struct Gemm { const bf16_t* A; const bf16_t* Bt; int M, N, K; };

struct StaticOrder {
    int nM, nN, nwg, G, c;
    __host__ __device__ void init(int M, int N, int G_, int c_) { nM = M / BM; nN = N / BM; nwg = nM * nN; G = G_; c = c_; }
    __host__ __device__ bool next(int i, Unit& u) const {
        const long L = (long)i * G + c; if (L >= nwg) return false;
        int wgid = (int)L; { const int q = nwg / NXCD, r = nwg % NXCD, xcd = wgid % NXCD, off = wgid / NXCD; wgid = (xcd < r ? xcd * (q + 1) : r * (q + 1) + (xcd - r) * q) + off; }
        const int nig = WGM * nN, gid = wgid / nig, fm = gid * WGM, gsz = (nM - fm) < WGM ? (nM - fm) : WGM;
        u.pm = fm + ((wgid % nig) % gsz); u.pn = (wgid % nig) / gsz; return true;
    }
    __device__ __forceinline__ void a_ready(const Unit&) const {}
    __device__ __forceinline__ void done(const Unit&) const {}
};

__device__ __forceinline__ unsigned cvt_pk_bf16(float lo, float hi) { unsigned r; asm volatile("v_cvt_pk_bf16_f32 %0, %1, %2" : "=v"(r) : "v"(lo), "v"(hi)); return r; }

template <class Epi, class Sched, bool ALIGN_EPI = false, bool SP2 = false>
__device__ __forceinline__ void gemm_phase(PG8_LAS unsigned char* lds, const Gemm g, const Sched& S, const Epi& E) {
    int tid_ = threadIdx.x; asm volatile("" : "+v"(tid_));
    const int tid = tid_, wid = __builtin_amdgcn_readfirstlane(tid >> 6), lane = tid & 63, wr = wid >> 2, wc = wid & 3, fr = lane & 15, fq = lane >> 4;
    const int K = g.K, nt = K / BK;
    unsigned voffA[2], voffB[2];
#pragma unroll
    for (int i = 0; i < 2; ++i) { int R, C; stage_rc(tid * 16 + i * 8192, R, C); const int Rb = Epi::PERM ? ((R & ~31) + perm32(R & 31)) : R;
        voffA[i] = (unsigned)(R * K + C) * 2u; voffB[i] = (unsigned)(Rb * K + C) * 2u; }
    const size_t kstep = (size_t)(BK * 2);
    const size_t hstep = (size_t)HALF * K * 2;
    const size_t tstep = 2 * hstep;
    const unsigned ldsw = (unsigned)wid * 1024u;
    const int aoff = lds_byte(wr * 64 + fr, fq * 8), boff = lds_byte(wc * 32 + fr, fq * 8);
#define PG8_SA(b, h) (((b) * 2 + (h)) * HTB)
#define PG8_SB(b, h) ((4 + (b) * 2 + (h)) * HTB)
#define PG8_STAGE(bufoff, gbase, voff) do { _Pragma("unroll") for (int _i = 0; _i < 2; ++_i) \
        __builtin_amdgcn_global_load_lds((const unsigned*)((const char*)(gbase) + (voff)[_i]), (PG8_LAS unsigned*)(lds + (bufoff) + ldsw + _i * 8192), 16, 0, 0); } while (0)
#define PG8_LDA(dst, b, h) do { _Pragma("unroll") for (int m = 0; m < 4; ++m) _Pragma("unroll") for (int k = 0; k < 2; ++k) dst[m][k] = *(const PG8_LAS bf16x8*)(lds + PG8_SA(b, h) + aoff + m * 2048 + k * 1024); } while (0)
#define PG8_LDB(dst, b, h) do { _Pragma("unroll") for (int n = 0; n < 2; ++n) _Pragma("unroll") for (int k = 0; k < 2; ++k) dst[n][k] = *(const PG8_LAS bf16x8*)(lds + PG8_SB(b, h) + boff + n * 2048 + k * 1024); } while (0)
#define PG8_MMA(ai, bj, At, Bt) do { __builtin_amdgcn_s_setprio(1); _Pragma("unroll") for (int m = 0; m < 4; ++m) _Pragma("unroll") for (int n = 0; n < 2; ++n) _Pragma("unroll") for (int k = 0; k < 2; ++k) \
        acc[ai][bj][m][n] = __builtin_amdgcn_mfma_f32_16x16x32_bf16(Bt[n][k], At[m][k], acc[ai][bj][m][n], 0, 0, 0); __builtin_amdgcn_s_setprio(0); } while (0)
#define PG8_WAIT_V(n) asm volatile("s_waitcnt vmcnt(" #n ")" ::: "memory")
#define PG8_WAIT_L(n) asm volatile("s_waitcnt lgkmcnt(" #n ")" ::: "memory")
#define PG8_BAR __builtin_amdgcn_s_barrier()
#define PG8_SCHED __builtin_amdgcn_sched_barrier(0)
    Unit cur, nxt; int ui = 0;
    if (!S.next(0, cur)) return;
    f32x4 acc[2][2][4][2];
#pragma unroll
    for (int a = 0; a < 2; ++a)
#pragma unroll
        for (int b = 0; b < 2; ++b)
#pragma unroll
            for (int m = 0; m < 4; ++m)
#pragma unroll
                for (int n = 0; n < 2; ++n) acc[a][b][m][n] = (f32x4){0.f, 0.f, 0.f, 0.f};
    bf16x8 At[4][2], B0[2][2], B1[2][2];
    const char* cA = (const char*)g.A + (size_t)cur.pm * tstep; const char* cB = (const char*)g.Bt + (size_t)cur.pn * tstep;
    S.a_ready(cur);
    if constexpr (SP2) {
        PG8_STAGE(PG8_SB(0, 0), cB, voffB); PG8_STAGE(PG8_SB(0, 1), cB + hstep, voffB); PG8_STAGE(PG8_SA(0, 0), cA, voffA); PG8_STAGE(PG8_SA(0, 1), cA + hstep, voffA);
        if (wr == 1) PG8_BAR;
        PG8_WAIT_V(2); PG8_BAR;
        PG8_STAGE(PG8_SB(1, 0), cB + kstep, voffB); PG8_STAGE(PG8_SA(1, 0), cA + kstep, voffA); PG8_STAGE(PG8_SB(1, 1), cB + hstep + kstep, voffB);
        PG8_WAIT_V(6); PG8_BAR;
    } else {
        PG8_STAGE(PG8_SB(0, 0), cB, voffB); PG8_STAGE(PG8_SA(0, 0), cA, voffA); PG8_STAGE(PG8_SB(0, 1), cB + hstep, voffB); PG8_STAGE(PG8_SA(0, 1), cA + hstep, voffA);
        if (wr == 1) PG8_BAR;
        PG8_WAIT_V(4); PG8_BAR;
        PG8_STAGE(PG8_SB(1, 0), cB + kstep, voffB); PG8_STAGE(PG8_SA(1, 0), cA + kstep, voffA); PG8_STAGE(PG8_SB(1, 1), cB + hstep + kstep, voffB);
        PG8_WAIT_V(6); PG8_BAR;
    }
    for (;;) {
        const bool has_next = S.next(ui + 1, nxt);
        const char* nA = has_next ? (const char*)g.A + (size_t)nxt.pm * tstep : cA; const char* nB = has_next ? (const char*)g.Bt + (size_t)nxt.pn * tstep : cB;
        for (int t = 0; t < nt; t += 2) {
            const bool last = (t == nt - 2);
            const char* a1 = cA + (size_t)(t + 1) * kstep;
            const char* a2 = last ? nA : cA + (size_t)(t + 2) * kstep; const char* b2 = last ? nB : cB + (size_t)(t + 2) * kstep;
            const char* a3 = a2 + kstep; const char* b3 = b2 + kstep;
            if (last && has_next) S.a_ready(nxt);
            if constexpr (SP2) {
            PG8_LDB(B0, 0, 0); PG8_LDB(B1, 0, 1); PG8_SCHED; PG8_LDA(At, 0, 0); PG8_STAGE(PG8_SA(1, 1), a1 + hstep, voffA);
            PG8_WAIT_V(8); PG8_WAIT_L(0); PG8_BAR; PG8_MMA(0, 0, At, B0); PG8_MMA(0, 1, At, B1); PG8_BAR; PG8_SCHED;
            PG8_LDA(At, 0, 1); PG8_STAGE(PG8_SB(0, 0), b2, voffB); PG8_STAGE(PG8_SB(0, 1), b2 + hstep, voffB); PG8_STAGE(PG8_SA(0, 0), a2, voffA);
            PG8_WAIT_V(8); PG8_WAIT_L(0); PG8_BAR; PG8_MMA(1, 0, At, B0); PG8_MMA(1, 1, At, B1); PG8_BAR; PG8_SCHED;
            PG8_LDB(B0, 1, 0); PG8_LDB(B1, 1, 1); PG8_SCHED; PG8_LDA(At, 1, 0); PG8_STAGE(PG8_SA(0, 1), a2 + hstep, voffA);
            PG8_WAIT_V(8); PG8_WAIT_L(0); PG8_BAR; PG8_MMA(0, 0, At, B0); PG8_MMA(0, 1, At, B1); PG8_BAR; PG8_SCHED;
            PG8_LDA(At, 1, 1); PG8_STAGE(PG8_SB(1, 0), b3, voffB); PG8_STAGE(PG8_SB(1, 1), b3 + hstep, voffB); PG8_STAGE(PG8_SA(1, 0), a3, voffA);
            PG8_WAIT_V(8); PG8_WAIT_L(0); PG8_BAR; PG8_MMA(1, 0, At, B0); PG8_MMA(1, 1, At, B1); PG8_BAR; PG8_SCHED;
            } else {
            PG8_LDB(B0, 0, 0); PG8_SCHED; PG8_LDA(At, 0, 0); PG8_STAGE(PG8_SA(1, 1), a1 + hstep, voffA);
            PG8_WAIT_L(8); PG8_BAR; PG8_WAIT_L(0); PG8_MMA(0, 0, At, B0); PG8_BAR; PG8_SCHED;
            PG8_LDB(B1, 0, 1); PG8_STAGE(PG8_SB(0, 0), b2, voffB);
            PG8_BAR; PG8_WAIT_L(0); PG8_MMA(0, 1, At, B1); PG8_BAR;
            PG8_LDA(At, 0, 1); PG8_STAGE(PG8_SA(0, 0), a2, voffA);
            PG8_BAR; PG8_WAIT_L(0); PG8_MMA(1, 0, At, B0); PG8_BAR; PG8_SCHED;
            PG8_STAGE(PG8_SB(0, 1), b2 + hstep, voffB);
            PG8_WAIT_V(6); PG8_BAR; PG8_MMA(1, 1, At, B1); PG8_BAR;
            PG8_LDB(B0, 1, 0); PG8_SCHED; PG8_LDA(At, 1, 0); PG8_STAGE(PG8_SA(0, 1), a2 + hstep, voffA);
            PG8_WAIT_L(8); PG8_BAR; PG8_WAIT_L(0); PG8_MMA(0, 0, At, B0); PG8_BAR; PG8_SCHED;
            PG8_LDB(B1, 1, 1); PG8_STAGE(PG8_SB(1, 0), b3, voffB);
            PG8_BAR; PG8_WAIT_L(0); PG8_MMA(0, 1, At, B1); PG8_BAR;
            PG8_LDA(At, 1, 1); PG8_STAGE(PG8_SA(1, 0), a3, voffA);
            PG8_BAR; PG8_WAIT_L(0); PG8_MMA(1, 0, At, B0); PG8_BAR; PG8_SCHED;
            PG8_STAGE(PG8_SB(1, 1), b3 + hstep, voffB);
            PG8_WAIT_V(6); PG8_BAR; PG8_MMA(1, 1, At, B1); PG8_BAR;
            }
        }
        if constexpr (ALIGN_EPI) { if (wr == 0) PG8_BAR; }
        E(acc, cur, wr, wc, fr, fq); S.done(cur);
        if (!has_next) break;
#pragma unroll
        for (int a = 0; a < 2; ++a)
#pragma unroll
            for (int b = 0; b < 2; ++b)
#pragma unroll
                for (int m = 0; m < 4; ++m)
#pragma unroll
                    for (int n = 0; n < 2; ++n) acc[a][b][m][n] = (f32x4){0.f, 0.f, 0.f, 0.f};
        cur = nxt; cA = nA; cB = nB; ++ui;
        if constexpr (ALIGN_EPI) { if (wr == 1) PG8_BAR; }
    }
    PG8_WAIT_V(0);
    if constexpr (!ALIGN_EPI) { if (wr == 0) PG8_BAR; }
    PG8_BAR;
#undef PG8_SA
#undef PG8_SB
#undef PG8_STAGE
#undef PG8_LDA
#undef PG8_LDB
#undef PG8_MMA
#undef PG8_WAIT_V
#undef PG8_WAIT_L
#undef PG8_BAR
#undef PG8_SCHED
}
}

constexpr int NWAVES = 8, NTHR = NWAVES * 64;
constexpr int DM = 1024, BATCH = 8, SEQ = 2048, DEPTH = 2, DECB = 128, PAST = 16384;
constexpr int MP = BATCH * SEQ;
constexpr int MT = MP + DECB;
constexpr int MPAD = 16640;
constexpr int NIN = 7168, MIXW = 2048, CH = 128, NH = 8, HD = 128, NCH = SEQ / CH;
constexpr float EPS = 1e-6f;

constexpr size_t MiB = 1u << 20;
constexpr size_t WS_CTL = 0, CTL_ZERO_BYTES = 64 * 1024;
constexpr size_t WS_WT1 = 1 * MiB;
constexpr size_t WS_WT2 = 29 * MiB;
constexpr size_t WS_WG  = 37 * MiB;
constexpr size_t WS_ROPE = 37 * MiB + 512 * 1024;
constexpr size_t WS_RS  = 39 * MiB;
constexpr size_t WS_LNS = 41 * MiB;
constexpr size_t WS_XB  = 44 * MiB;
constexpr size_t WS_H32 = 77 * MiB;
constexpr size_t PROJ_BYTES = (size_t)MPAD * 1024 * 2;
constexpr size_t WS_Q   = 142 * MiB;
constexpr size_t WS_K   = WS_Q + PROJ_BYTES;
constexpr size_t WS_V   = WS_K + PROJ_BYTES;
constexpr size_t WS_SGR = WS_V + PROJ_BYTES;
constexpr size_t WS_UG  = WS_SGR + PROJ_BYTES;
constexpr size_t WS_VG  = WS_UG + PROJ_BYTES;
constexpr size_t WS_CAT = 337 * MiB;
constexpr size_t WS_ST  = 402 * MiB;
constexpr size_t WS_END = 434 * MiB;
static_assert(WS_VG + PROJ_BYTES <= WS_CAT && WS_H32 + (size_t)MT * 1024 * 4 <= WS_Q && WS_XB + PROJ_BYTES <= WS_H32, "ws map");

constexpr size_t OUT_Y   = 0;
constexpr size_t OUT_SP  = (size_t)MT * 1024;
constexpr size_t OUT_SS  = OUT_SP + (size_t)DEPTH * BATCH * NH * HD * HD;
constexpr size_t OUT_GV  = OUT_SS + (size_t)DEPTH * DECB * NH * HD * HD;

constexpr int RING_OFF = 0, RING_BYTES = 131072;
constexpr int LDS_BYTES = 147456;
constexpr int MISC_OFF = LDS_BYTES - 512;

#define GAS __attribute__((address_space(1)))
#define LAS __attribute__((address_space(3)))
typedef unsigned short bf16;
typedef unsigned v4u __attribute__((ext_vector_type(4)));
typedef unsigned v2u __attribute__((ext_vector_type(2)));
typedef float f32x4 __attribute__((ext_vector_type(4)));
typedef float f32x2 __attribute__((ext_vector_type(2)));
#define LDS_WAIT() asm volatile("s_waitcnt lgkmcnt(0)" ::: "memory")
__device__ __forceinline__ unsigned f2bf(float f) { unsigned u = __builtin_bit_cast(unsigned, f); return (u + 0x7fffu + ((u >> 16) & 1u)) >> 16; }
__device__ __forceinline__ unsigned pk2(float lo, float hi) { return f2bf(lo) | (f2bf(hi) << 16); }
__device__ __forceinline__ float bf2f(unsigned b) { return __builtin_bit_cast(float, b << 16); }
__device__ __forceinline__ float bflo(unsigned w) { return __builtin_bit_cast(float, w << 16); }
__device__ __forceinline__ float bfhi(unsigned w) { return __builtin_bit_cast(float, w & 0xffff0000u); }
__device__ __forceinline__ float silu_f(float x) { return x / (1.0f + __expf(-x)); }
__device__ __forceinline__ float wave_sum(float v) {
#pragma unroll
    for (int o = 1; o < 64; o <<= 1) v += __shfl_xor(v, o);
    return v;
}
__device__ __forceinline__ float lg2gamma(int h) {
    return h == 0 ? -0.04580368961312479f : h == 1 ? -0.02272007650008353f : h == 2 ? -0.011315313227834146f : h == 3 ? -0.005646563141142063f :
           h == 4 ? -0.0028205190623786626f : h == 5 ? -0.0014095702546713536f : h == 6 ? -0.0007046129765893727f : -0.0003522634716290214f;
}

#define XB_TMO      128
#define XB_XCNT(j)  (256  + 64 * (j))
#define XB_XSUB(j)  (1280 + 64 * (j))
#define XB_XGEN(j)  (2304 + 64 * (j))
#define XB_TOP      3328
#define XB_TOPGEN   3392
#define XCD_BAR_WORDS 3456
#define XB_SPIN_CAP (1u << 18)
__device__ __forceinline__ unsigned xb_ld(unsigned* p)              { return __hip_atomic_load(p, __ATOMIC_RELAXED, __HIP_MEMORY_SCOPE_AGENT); }
__device__ __forceinline__ unsigned xb_add(unsigned* p, unsigned v) { return __hip_atomic_fetch_add(p, v, __ATOMIC_RELAXED, __HIP_MEMORY_SCOPE_AGENT); }
__device__ __forceinline__ unsigned xb_xcc_id() { return (unsigned)__builtin_amdgcn_s_getreg((3 << 11) | 20) & 0xFu; }
#define XB_SPIN(cond, bar) do { unsigned _sp = 0; while (cond) { __builtin_amdgcn_s_sleep(1); \
    if ((++_sp & 255u) == 0u) { if (xb_ld(&(bar)[XB_TMO])) break; if (_sp > XB_SPIN_CAP) { atomicAdd(&(bar)[XB_TMO], 1u); break; } } } } while (0)
struct XcdBarrier { unsigned* bar; unsigned x; volatile LAS unsigned* st; };
__device__ __forceinline__ XcdBarrier xcd_barrier_post(unsigned* bar, volatile LAS unsigned* st) {
    XcdBarrier b; b.bar = bar; b.x = xb_xcc_id(); b.st = st;
    if (threadIdx.x == 0) (void)xb_add(&bar[XB_XCNT(b.x)], 1u);
    return b;
}
__device__ __forceinline__ void xcd_barrier_complete(unsigned* bar, unsigned x, unsigned& nloc, unsigned& nx) {
    const unsigned G = gridDim.x * gridDim.y * gridDim.z;
    unsigned sum, cnt, mine, sp = 0u;
    for (;;) {
        sum = 0u; cnt = 0u; mine = 0u;
#pragma unroll
        for (unsigned j = 0; j < 16; ++j) { const unsigned c = xb_ld(&bar[XB_XCNT(j)]); sum += c; cnt += (c > 0u) ? 1u : 0u; mine = (j == x) ? c : mine; }
        if (sum == G) break;
        __builtin_amdgcn_s_sleep(1);
        if ((++sp & 255u) == 0u) { if (xb_ld(&bar[XB_TMO])) break; if (sp > XB_SPIN_CAP) { atomicAdd(&bar[XB_TMO], 1u); break; } }
    }
    nloc = mine > 0u ? mine : 1u; nx = cnt > 0u ? cnt : 1u;
}
__device__ __forceinline__ void xcd_barrier(const XcdBarrier& b) {
    asm volatile("s_waitcnt vmcnt(0)" ::: "memory");
    __syncthreads();
    if (threadIdx.x == 0) {
        unsigned* bar = b.bar;
        __builtin_amdgcn_s_waitcnt(0);
        unsigned nloc = b.st[0], nx = b.st[1];
        if (nloc == 0u) { xcd_barrier_complete(bar, b.x, nloc, nx); b.st[0] = nloc; b.st[1] = nx; }
        const unsigned old = xb_add(&bar[XB_XSUB(b.x)], 1u);
        const unsigned gen = old / nloc;
        if (old + 1u == (gen + 1u) * nloc) {
            __builtin_amdgcn_fence(__ATOMIC_RELEASE, "agent");
            asm volatile("s_waitcnt vmcnt(0)" ::: "memory");
            const unsigned og = xb_add(&bar[XB_TOP], 1u);
            const unsigned tg = og / nx;
            if (og + 1u == (tg + 1u) * nx) xb_add(&bar[XB_TOPGEN], 1u);
            else XB_SPIN(xb_ld(&bar[XB_TOPGEN]) == tg, bar);
            __builtin_amdgcn_fence(__ATOMIC_ACQUIRE, "agent");
            xb_add(&bar[XB_XGEN(b.x)], 1u);
            asm volatile("s_waitcnt vmcnt(0)" ::: "memory");
        } else {
            XB_SPIN(xb_ld(&bar[XB_XGEN(b.x)]) == gen, bar);
            __builtin_amdgcn_fence(__ATOMIC_ACQUIRE, "agent");
            asm volatile("s_waitcnt vmcnt(0)" ::: "memory");
        }
    }
    __syncthreads();
}

struct EpiProj {
    static constexpr bool PERM = true;
    unsigned char* ws;
    __device__ __forceinline__ void operator()(const pg8::f32x4 (&acc)[2][2][4][2], const pg8::Unit& u, int wr, int wc, int fr, int fq) const {
        bf16* const Q = (bf16*)(ws + WS_Q); bf16* const K = (bf16*)(ws + WS_K); bf16* const V = (bf16*)(ws + WS_V); bf16* const SGR = (bf16*)(ws + WS_SGR);
        bf16* const UG = (bf16*)(ws + WS_UG); bf16* const VG = (bf16*)(ws + WS_VG); const float* const RS = (const float*)(ws + WS_RS); float* const LNS = (float*)(ws + WS_LNS);
        const float* const rope = (const float*)(ws + WS_ROPE);
        const int pn = u.pn, rowb = u.pm * 256 + wr * 64 + fr;
#pragma unroll
        for (int ai = 0; ai < 2; ++ai)
#pragma unroll
            for (int m = 0; m < 4; ++m) {
                const int row = rowb + ai * 128 + m * 16;
                const f32x4* rp = (const f32x4*)(RS + (size_t)row * 16);
                const f32x4 r0 = rp[0], r1 = rp[1], r2 = rp[2], r3 = rp[3];
                const float ssq = ((r0.x + r0.y) + (r0.z + r0.w)) + ((r1.x + r1.y) + (r1.z + r1.w)) + ((r2.x + r2.y) + (r2.z + r2.w)) + ((r3.x + r3.y) + (r3.z + r3.w));
                const float rr = rsqrtf(ssq * (1.0f / 1024.0f) + EPS);
                if (pn < 8) {
                    const int head = 2 * (pn & 3) + (wc >> 1), f0 = 32 * (wc & 1) + 8 * fq;
                    const int pidx = row < MP ? (row & (SEQ - 1)) : SEQ;
                    const int ci = row < MP ? (row & (CH - 1)) : 0;
                    const float e = lg2gamma(head) * (float)(ci + 1);
                    const float sc = rr * (pn < 4 ? exp2f(e) : exp2f(-e) * 0.08838834764831845f);
                    const f32x4* cs = (const f32x4*)(rope + ((size_t)pidx * 64 + f0) * 2);
                    float o1[8], o2[8];
#pragma unroll
                    for (int t = 0; t < 4; ++t) { const f32x4 c4 = cs[t];
                        const int e0 = 2 * t, e1 = 2 * t + 1;
                        const float a0 = acc[ai][0][m][e0 >> 2][e0 & 3], b0 = acc[ai][1][m][e0 >> 2][e0 & 3];
                        const float a1 = acc[ai][0][m][e1 >> 2][e1 & 3], b1 = acc[ai][1][m][e1 >> 2][e1 & 3];
                        o1[e0] = (a0 * c4.x - b0 * c4.y) * sc; o2[e0] = (a0 * c4.y + b0 * c4.x) * sc;
                        o1[e1] = (a1 * c4.z - b1 * c4.w) * sc; o2[e1] = (a1 * c4.w + b1 * c4.z) * sc; }
                    bf16* dst = (pn < 4 ? Q : K) + (size_t)row * 1024 + 128 * head + f0;
                    pg8::u32x4 w1, w2;
                    w1.x = pg8::cvt_pk_bf16(o1[0], o1[1]); w1.y = pg8::cvt_pk_bf16(o1[2], o1[3]); w1.z = pg8::cvt_pk_bf16(o1[4], o1[5]); w1.w = pg8::cvt_pk_bf16(o1[6], o1[7]);
                    w2.x = pg8::cvt_pk_bf16(o2[0], o2[1]); w2.y = pg8::cvt_pk_bf16(o2[2], o2[3]); w2.z = pg8::cvt_pk_bf16(o2[4], o2[5]); w2.w = pg8::cvt_pk_bf16(o2[6], o2[7]);
                    *(pg8::u32x4*)dst = w1; *(pg8::u32x4*)(dst + 64) = w2;
                } else if (pn < 16) {
                    const bool isv = pn < 12;
                    bf16* dst = (isv ? V : SGR) + (size_t)row * 1024 + 256 * (isv ? pn - 8 : pn - 12) + 32 * wc + 8 * fq;
#pragma unroll
                    for (int bj = 0; bj < 2; ++bj) { f32x4 v0 = acc[ai][bj][m][0] * rr, v1 = acc[ai][bj][m][1] * rr;
                        if (!isv) {
#pragma unroll
                            for (int j = 0; j < 4; ++j) { v0[j] = silu_f(v0[j]); v1[j] = silu_f(v1[j]); } }
                        pg8::u32x4 w; w.x = pg8::cvt_pk_bf16(v0[0], v0[1]); w.y = pg8::cvt_pk_bf16(v0[2], v0[3]); w.z = pg8::cvt_pk_bf16(v1[0], v1[1]); w.w = pg8::cvt_pk_bf16(v1[2], v1[3]);
                        *(pg8::u32x4*)(dst + 128 * bj) = w; }
                } else if (pn < 24) {
                    bf16* dst = UG + (size_t)row * 1024 + 128 * (pn - 16) + 32 * wc + 8 * fq;
                    f32x4 v0 = acc[ai][0][m][0] * rr, v1 = acc[ai][0][m][1] * rr; const f32x4 g0 = acc[ai][1][m][0] * rr, g1 = acc[ai][1][m][1] * rr;
#pragma unroll
                    for (int j = 0; j < 4; ++j) { v0[j] *= silu_f(g0[j]); v1[j] *= silu_f(g1[j]); }
                    pg8::u32x4 w; w.x = pg8::cvt_pk_bf16(v0[0], v0[1]); w.y = pg8::cvt_pk_bf16(v0[2], v0[3]); w.z = pg8::cvt_pk_bf16(v1[0], v1[1]); w.w = pg8::cvt_pk_bf16(v1[2], v1[3]);
                    *(pg8::u32x4*)dst = w;
                } else {
                    bf16* dst = VG + (size_t)row * 1024 + 256 * (pn - 24) + 32 * wc + 8 * fq;
                    float s1 = 0.f, s2 = 0.f;
#pragma unroll
                    for (int bj = 0; bj < 2; ++bj) { const f32x4 v0 = acc[ai][bj][m][0] * rr, v1 = acc[ai][bj][m][1] * rr;
#pragma unroll
                        for (int j = 0; j < 4; ++j) { s1 += v0[j] + v1[j]; s2 += v0[j] * v0[j] + v1[j] * v1[j]; }
                        pg8::u32x4 w; w.x = pg8::cvt_pk_bf16(v0[0], v0[1]); w.y = pg8::cvt_pk_bf16(v0[2], v0[3]); w.z = pg8::cvt_pk_bf16(v1[0], v1[1]); w.w = pg8::cvt_pk_bf16(v1[2], v1[3]);
                        *(pg8::u32x4*)(dst + 128 * bj) = w; }
                    s1 += __shfl_xor(s1, 16); s1 += __shfl_xor(s1, 32); s2 += __shfl_xor(s2, 16); s2 += __shfl_xor(s2, 32);
                    if (fq == 0) *(f32x2*)(LNS + ((size_t)row * 16 + (pn - 24) * 4 + wc) * 2) = (f32x2){s1, s2};
                }
            }
    }
};
struct EpiRes {
    static constexpr bool PERM = false;
    const float* res_p; const float* res_s; float* out; unsigned char* ws;
    __device__ __forceinline__ void operator()(const pg8::f32x4 (&acc)[2][2][4][2], const pg8::Unit& u, int wr, int wc, int fr, int fq) const {
        bf16* const XB = (bf16*)(ws + WS_XB); float* const RS = (float*)(ws + WS_RS);
        const int rowb = u.pm * 256 + wr * 64 + fr, colb = u.pn * 256 + wc * 32 + 4 * fq;
#pragma unroll
        for (int ai = 0; ai < 2; ++ai)
#pragma unroll
            for (int m = 0; m < 4; ++m) {
                const int row = rowb + ai * 128 + m * 16; const bool ok = row < MT;
                float ssq = 0.f;
                if (ok) {
                    const float* rsrc = (row < MP ? res_p + (size_t)row * 1024 : res_s + (size_t)(row - MP) * 1024) + colb;
                    float* o = out + (size_t)row * 1024 + colb; bf16* xb = XB + (size_t)row * 1024 + colb;
#pragma unroll
                    for (int bj = 0; bj < 2; ++bj)
#pragma unroll
                        for (int n = 0; n < 2; ++n) { const f32x4 hn = *(const f32x4*)(rsrc + bj * 128 + n * 16) + acc[ai][bj][m][n];
                            *(f32x4*)(o + bj * 128 + n * 16) = hn; ssq += (hn.x * hn.x + hn.y * hn.y) + (hn.z * hn.z + hn.w * hn.w);
                            pg8::u32x2 w; w.x = pg8::cvt_pk_bf16(hn.x, hn.y); w.y = pg8::cvt_pk_bf16(hn.z, hn.w); *(pg8::u32x2*)(xb + bj * 128 + n * 16) = w; }
                }
                ssq += __shfl_xor(ssq, 16); ssq += __shfl_xor(ssq, 32);
                if (ok && fq == 0) RS[(size_t)row * 16 + u.pn * 4 + wc] = ssq;
            }
    }
};

struct Args { const float* in[11]; float* out; unsigned char* ws; int ph_lo, ph_hi; };

#define CAS __attribute__((address_space(4)))
__device__ __forceinline__ Args fresh_args() { const unsigned long long p0 = (unsigned long long)__builtin_amdgcn_kernarg_segment_ptr();
    unsigned plo = __builtin_amdgcn_readfirstlane((unsigned)p0), phi = __builtin_amdgcn_readfirstlane((unsigned)(p0 >> 32)); asm volatile("" : "+s"(plo), "+s"(phi));
    const CAS Args* q = (const CAS Args*)(((unsigned long long)phi << 32) | plo); Args r;
#pragma unroll
    for (int i = 0; i < 11; ++i) r.in[i] = q->in[i];
    r.out = q->out; r.ws = q->ws; r.ph_lo = q->ph_lo; r.ph_hi = q->ph_hi; return r; }
__device__ __forceinline__ int colmap(int np) {
    const int pn = np >> 8, tc = np & 255;
    if (pn < 8) { const int base = (pn < 4) ? 0 : 1024, head = 2 * (pn & 3) + ((tc & 127) >> 6), part = tc >> 7; return base + 128 * head + 64 * part + (tc & 63); }
    if (pn < 12) return 2048 + 256 * (pn - 8) + tc;
    if (pn < 16) return 3072 + 256 * (pn - 12) + tc;
    if (pn < 24) { const int head = pn - 16; return tc < 128 ? 4096 + 128 * head + tc : 6144 + 128 * head + (tc - 128); }
    return 5120 + 256 * (pn - 24) + tc;
}
__device__ __forceinline__ void p0_transpose_item(const float* W, int K, int N, bf16* WT, const float* gk, int k0, int src_n0, int dst_n0, LAS float* scr, int lane) {
#pragma unroll 8
    for (int i = 0; i < 32; ++i) { const int kk = 2 * i + (lane >> 5); float v = W[(size_t)(k0 + kk) * N + src_n0 + (lane & 31)]; if (gk) v *= gk[k0 + kk]; scr[kk * 33 + (lane & 31)] = v; }
    LDS_WAIT(); asm volatile("" ::: "memory");
    const int c = lane & 7;
#pragma unroll
    for (int j = 0; j < 4; ++j) { const int n = (lane >> 3) + 8 * j; const LAS float* s = scr + (8 * c) * 33 + n;
        v4u o; o.x = pk2(s[0 * 33], s[1 * 33]); o.y = pk2(s[2 * 33], s[3 * 33]); o.z = pk2(s[4 * 33], s[5 * 33]); o.w = pk2(s[6 * 33], s[7 * 33]);
        *(v4u*)(WT + (size_t)(dst_n0 + n) * K + k0 + 8 * c) = o; }
    LDS_WAIT(); asm volatile("" ::: "memory");
}
__device__ __forceinline__ void p0_prologue(const Args& a, LAS unsigned char* lds, int gw, int NGW, int lane, int wave) {
    LAS float* scr = (LAS float*)(lds + RING_OFF + wave * 16384);
    unsigned char* ws = a.ws;
    constexpr int I1 = (DM / 64) * (NIN / 32), I2 = (MIXW / 64) * (DM / 32), NITEMS = DEPTH * (I1 + I2);
    for (int it = gw; it < NITEMS; it += NGW) {
        const int l = it / (I1 + I2); int r = it % (I1 + I2);
        if (r < I1) { const int kb = r / (NIN / 32), nb = r % (NIN / 32);
            p0_transpose_item(a.in[4] + (size_t)l * DM * NIN, DM, NIN, (bf16*)(ws + WS_WT1) + (size_t)l * NIN * DM, a.in[3] + l * DM, 64 * kb, colmap(32 * nb), 32 * nb, scr, lane); }
        else { r -= I1; const int kb = r / (DM / 32), nb = r % (DM / 32);
            p0_transpose_item(a.in[5] + (size_t)l * MIXW * DM, MIXW, DM, (bf16*)(ws + WS_WT2) + (size_t)l * DM * MIXW, nullptr, 64 * kb, 32 * nb, 32 * nb, scr, lane); }
    }
    for (int m = gw; m < MT; m += NGW) {
        const float* xrow = m < MP ? a.in[0] + (size_t)m * DM : a.in[1] + (size_t)(m - MP) * DM;
        const f32x4* xr = (const f32x4*)xrow + lane; f32x4 v[4]; float s = 0.f;
#pragma unroll
        for (int j = 0; j < 4; ++j) { v[j] = xr[64 * j]; s += (v[j].x * v[j].x + v[j].y * v[j].y) + (v[j].z * v[j].z + v[j].w * v[j].w); }
        s = wave_sum(s);
        unsigned long long* o8 = (unsigned long long*)((bf16*)(ws + WS_XB) + (size_t)m * DM) + lane;
#pragma unroll
        for (int j = 0; j < 4; ++j) o8[64 * j] = (unsigned long long)pk2(v[j].x, v[j].y) | ((unsigned long long)pk2(v[j].z, v[j].w) << 32);
        if (lane < 16) ((float*)(ws + WS_RS))[(size_t)m * 16 + lane] = lane == 0 ? s : 0.f;
    }
    const int gt = gw * 64 + lane, NGT = NGW * 64;
    for (int i = gt; i < (SEQ + 1) * 64; i += NGT) {
        const int pidx = i >> 6, f = i & 63; const double pos = pidx < SEQ ? (double)pidx : (double)PAST;
        double inv = 1.0; for (int j = 0; j < f; ++j) inv *= 0.8659643233600653;
        const double ang = pos * inv; const double q = __builtin_rint(ang * 0.63661977236758134308);
        double r = __builtin_fma(-q, 1.5707963267948966, ang); r = __builtin_fma(-q, 6.123233995736766e-17, r);
        const double r2 = r * r;
        const double sn = r * (1.0 + r2 * (-1.0 / 6 + r2 * (1.0 / 120 + r2 * (-1.0 / 5040 + r2 * (1.0 / 362880 + r2 * (-1.0 / 39916800 + r2 * (1.0 / 6227020800.0)))))));
        const double cs = 1.0 + r2 * (-0.5 + r2 * (1.0 / 24 + r2 * (-1.0 / 720 + r2 * (1.0 / 40320 + r2 * (-1.0 / 3628800 + r2 * (1.0 / 479001600.0))))));
        const int qi = ((int)q) & 3;
        const double c = qi == 0 ? cs : qi == 1 ? -sn : qi == 2 ? -cs : sn;
        const double s = qi == 0 ? sn : qi == 1 ? cs : qi == 2 ? -sn : -cs;
        ((f32x2*)(ws + WS_ROPE))[i] = (f32x2){(float)c, (float)s};
    }
    for (int i = gt; i < DEPTH * NH * CH * CH; i += NGT) { const int jj = i & 127, ii = (i >> 7) & 127; ((bf16*)(ws + WS_WG))[i] = jj <= ii ? (bf16)f2bf(a.in[6][i]) : (bf16)0; }
}

__device__ __forceinline__ void sample_ret_item(const Args& a, int l, int item, int lane) {
    const int b = item >> 3, h = item & 7; const size_t row = (size_t)MP + b;
    const bf16* Qg = (const bf16*)(a.ws + WS_Q) + row * 1024 + 128 * h; const bf16* Kg = (const bf16*)(a.ws + WS_K) + row * 1024 + 128 * h;
    const bf16* Vg = (const bf16*)(a.ws + WS_V) + row * 1024 + 128 * h; const bf16* Gg = (const bf16*)(a.ws + WS_SGR) + row * 1024 + 128 * h;
    const int c4 = lane & 31, r2 = lane >> 5;
    const float* S0 = a.in[2] + ((((size_t)l * DECB + b) * NH + h) * HD) * HD + (size_t)r2 * HD + 4 * c4;
    float* S1 = a.out + OUT_SS + ((((size_t)l * DECB + b) * NH + h) * HD) * HD + (size_t)r2 * HD + 4 * c4;
    const float gam = exp2f(lg2gamma(h));
    const unsigned qw = *(const unsigned*)(Qg + 2 * lane), kw = *(const unsigned*)(Kg + 2 * lane);
    const v2u vw = *(const v2u*)(Vg + 4 * c4), gw = *(const v2u*)(Gg + 4 * c4);
    const float v0 = bflo(vw.x), v1 = bfhi(vw.x), v2 = bflo(vw.y), v3 = bfhi(vw.y);
    f32x4 o = {0.f, 0.f, 0.f, 0.f};
#pragma unroll
    for (int tb = 0; tb < 4; ++tb) {
        f32x4 sv[16];
#pragma unroll
        for (int u = 0; u < 16; ++u) sv[u] = *(const f32x4*)(S0 + (size_t)(2 * (16 * tb + u)) * HD);
#pragma unroll
        for (int u = 0; u < 16; ++u) { const int t = 16 * tb + u;
            const unsigned qq = __shfl(qw, t), kk = __shfl(kw, t);
            const float qd = r2 ? bfhi(qq) : bflo(qq), kd = r2 ? bfhi(kk) : bflo(kk);
            f32x4 t1; t1.x = sv[u].x + kd * v0; t1.y = sv[u].y + kd * v1; t1.z = sv[u].z + kd * v2; t1.w = sv[u].w + kd * v3;
            o += t1 * qd; *(f32x4*)(S1 + (size_t)(2 * t) * HD) = t1 * gam; }
    }
    o.x += __shfl_xor(o.x, 32); o.y += __shfl_xor(o.y, 32); o.z += __shfl_xor(o.z, 32); o.w += __shfl_xor(o.w, 32);
    float ss = (o.x * o.x + o.y * o.y) + (o.z * o.z + o.w * o.w);
#pragma unroll
    for (int s = 1; s < 32; s <<= 1) ss += __shfl_xor(ss, s);
    const float rs = rsqrtf(ss * (1.0f / 128.0f) + EPS);
    if (r2 == 0) { v2u w; w.x = pk2(o.x * rs * bflo(gw.x), o.y * rs * bfhi(gw.x)); w.y = pk2(o.z * rs * bflo(gw.y), o.w * rs * bfhi(gw.y));
        *(v2u*)((bf16*)(a.ws + WS_CAT) + row * 2048 + 128 * h + 4 * c4) = w; }
}
__device__ __forceinline__ void sample_gm_item(const Args& a, int l, int b, int lane) {
    const size_t row = (size_t)MP + b;
    const f32x4* lp = (const f32x4*)((const float*)(a.ws + WS_LNS) + row * 32); float s1 = 0.f, s2 = 0.f;
#pragma unroll
    for (int i = 0; i < 8; ++i) { const f32x4 p = lp[i]; s1 += p.x + p.z; s2 += p.y + p.w; }
    const float mu = s1 * (1.0f / 1024.0f), var = s2 * (1.0f / 1024.0f) - mu * mu, rstd = rsqrtf(var + EPS);
    const bf16* vg = (const bf16*)(a.ws + WS_VG) + row * 1024; const bf16* ug = (const bf16*)(a.ws + WS_UG) + row * 1024;
    float* gv = a.out + OUT_GV + ((size_t)l * DECB + b) * 1024; bf16* cat = (bf16*)(a.ws + WS_CAT) + row * 2048 + 1024;
    v2u vw[4], uw[4]; f32x4 lg[4], lb[4]; float w00[4], b0[4];
#pragma unroll
    for (int j = 0; j < 4; ++j) { const int c = 4 * lane + 256 * j, h = c >> 7;
        vw[j] = *(const v2u*)(vg + c); uw[j] = *(const v2u*)(ug + c); lg[j] = *(const f32x4*)(a.in[8] + l * 1024 + c); lb[j] = *(const f32x4*)(a.in[9] + l * 1024 + c);
        w00[j] = a.in[6][((size_t)l * NH + h) * CH * CH]; b0[j] = a.in[7][((size_t)l * NH + h) * CH]; }
#pragma unroll
    for (int j = 0; j < 4; ++j) { const int c = 4 * lane + 256 * j;
        f32x4 vn; vn.x = (bflo(vw[j].x) - mu) * rstd * lg[j].x + lb[j].x; vn.y = (bfhi(vw[j].x) - mu) * rstd * lg[j].y + lb[j].y;
        vn.z = (bflo(vw[j].y) - mu) * rstd * lg[j].z + lb[j].z; vn.w = (bfhi(vw[j].y) - mu) * rstd * lg[j].w + lb[j].w;
        *(f32x4*)(gv + c) = vn;
        v2u w; w.x = pk2((w00[j] * vn.x + b0[j]) * bflo(uw[j].x), (w00[j] * vn.y + b0[j]) * bfhi(uw[j].x)); w.y = pk2((w00[j] * vn.z + b0[j]) * bflo(uw[j].y), (w00[j] * vn.w + b0[j]) * bfhi(uw[j].y));
        *(v2u*)(cat + c) = w; }
}
typedef short s16x4 __attribute__((ext_vector_type(4)));
typedef short bf16x8 __attribute__((ext_vector_type(8)));
typedef float f32x16 __attribute__((ext_vector_type(16)));
typedef __bf16 bf16x2v __attribute__((ext_vector_type(2)));
#define MFMA32(a, b, c) __builtin_amdgcn_mfma_f32_32x32x16_bf16((a), (b), (c), 0, 0, 0)
__device__ __forceinline__ unsigned pkbf(float lo, float hi) { const bf16x2v r = __builtin_convertvector((f32x2){lo, hi}, bf16x2v); return __builtin_bit_cast(unsigned, r); }
__device__ __forceinline__ unsigned offb(unsigned row, unsigned ch) { return 256u * row + 16u * (ch ^ (((row & 3u) << 2) | ((row >> 2) & 3u))); }
__device__ __forceinline__ bf16x8 rowfrag(LAS unsigned char* tile, int R0, int lane, int s) { return *(const LAS bf16x8*)(tile + offb(R0 + (lane & 31), 2 * s + (lane >> 5))); }
template <bool PERMK> __device__ __forceinline__ bf16x8 trfrag(LAS unsigned char* tile, int R0, int lane, int c, int ks) {
    const int hh = lane >> 5, blk = (lane >> 4) & 1, q = (lane & 15) >> 2, p = lane & 3;
    const int r0 = R0 + 16 * ks + (PERMK ? 4 * hh : 8 * hh) + q, r1 = r0 + (PERMK ? 8 : 4), ch = 4 * c + 2 * blk + (p >> 1);
    const s16x4 lo = __builtin_amdgcn_ds_read_tr16_b64_v4i16((LAS s16x4*)(tile + offb(r0, ch) + 8 * (p & 1)));
    const s16x4 hi = __builtin_amdgcn_ds_read_tr16_b64_v4i16((LAS s16x4*)(tile + offb(r1, ch) + 8 * (p & 1)));
    return __builtin_shufflevector(lo, hi, 0, 1, 2, 3, 4, 5, 6, 7);
}
__device__ __forceinline__ bf16x8 trfrag64(LAS unsigned char* tile, int lane, int ks) {
    const int hh = lane >> 5, blk = (lane >> 4) & 1, q = (lane & 15) >> 2, p = lane & 3;
    const int r0 = 16 * ks + 8 * hh + q; const int cb = (2 * blk + (p >> 1)) * 16 + 8 * (p & 1);
    const s16x4 lo = __builtin_amdgcn_ds_read_tr16_b64_v4i16((LAS s16x4*)(tile + r0 * 64 + cb));
    const s16x4 hi = __builtin_amdgcn_ds_read_tr16_b64_v4i16((LAS s16x4*)(tile + (r0 + 4) * 64 + cb));
    return __builtin_shufflevector(lo, hi, 0, 1, 2, 3, 4, 5, 6, 7);
}
__device__ __forceinline__ bf16x8 packx(const f32x16& x, int s) {
    v4u p; p.x = pkbf(x[8 * s + 0], x[8 * s + 1]); p.y = pkbf(x[8 * s + 2], x[8 * s + 3]); p.z = pkbf(x[8 * s + 4], x[8 * s + 5]); p.w = pkbf(x[8 * s + 6], x[8 * s + 7]);
    return __builtin_bit_cast(bf16x8, p);
}
__device__ __forceinline__ void stage_tile(LAS unsigned char* tile, const bf16* src, int ld, int tid) {
    v4u w[4];
#pragma unroll
    for (int i = 0; i < 4; ++i) { const int ch = tid + i * NTHR; w[i] = *(const v4u*)(src + (size_t)(ch >> 4) * ld + (ch & 15) * 8); }
#pragma unroll
    for (int i = 0; i < 4; ++i) { const int ch = tid + i * NTHR; *(LAS v4u*)(tile + offb(ch >> 4, ch & 15)) = w[i]; }
}
constexpr int T32K = 32768;

__device__ __forceinline__ void kvscan_wave(const Args& a, int l, int item, int dkb, LAS unsigned char* wl, int lane) {
    const int b = item >> 5, hd = (item >> 2) & 7, dq = item & 3, hh = lane >> 5, cl = lane & 31;
    LAS unsigned char* Kb = wl; LAS unsigned char* Vb = wl + 8192;
    const bf16* Kg = (const bf16*)(a.ws + WS_K) + (size_t)b * SEQ * 1024 + 128 * hd + 32 * dkb + (lane & 3) * 8 + (size_t)(lane >> 2) * 1024;
    const bf16* Vg = (const bf16*)(a.ws + WS_V) + (size_t)b * SEQ * 1024 + 128 * hd + 32 * dq + (lane & 3) * 8 + (size_t)(lane >> 2) * 1024;
    bf16* ST = (bf16*)(a.ws + WS_ST) + ((((size_t)b * NCH) * NH + hd) * HD + 32 * dq + cl) * HD + 32 * dkb + 4 * hh;
    f32x16 S;
#pragma unroll
    for (int i = 0; i < 16; ++i) S[i] = 0.f;
    const float g128 = exp2f(lg2gamma(hd) * 128.0f);
    v4u kr[8], vr[8];
#pragma unroll
    for (int i = 0; i < 8; ++i) { kr[i] = *(const v4u*)(Kg + (size_t)i * 16 * 1024); vr[i] = *(const v4u*)(Vg + (size_t)i * 16 * 1024); }
    for (int c = 0; c < NCH; ++c) {
        { bf16* st = ST + (size_t)c * NH * HD * HD;
#pragma unroll
          for (int g = 0; g < 4; ++g) { v2u o; o.x = pkbf(S[4 * g], S[4 * g + 1]); o.y = pkbf(S[4 * g + 2], S[4 * g + 3]); *(v2u*)(st + 8 * g) = o; } }
#pragma unroll
        for (int i = 0; i < 8; ++i) { *(LAS v4u*)(Kb + (lane + 64 * i) * 16) = kr[i]; *(LAS v4u*)(Vb + (lane + 64 * i) * 16) = vr[i]; }
        if (c + 1 < NCH) { const size_t o = (size_t)(c + 1) * CH * 1024;
#pragma unroll
            for (int i = 0; i < 8; ++i) { kr[i] = *(const v4u*)(Kg + o + (size_t)i * 16 * 1024); vr[i] = *(const v4u*)(Vg + o + (size_t)i * 16 * 1024); } }
#pragma unroll
        for (int ks = 0; ks < 8; ++ks) { const bf16x8 A = trfrag64(Kb, lane, ks); const bf16x8 B = trfrag64(Vb, lane, ks); S = MFMA32(A, B, S); }
#pragma unroll
        for (int i = 0; i < 16; ++i) S[i] *= g128;
    }
    float* so = a.out + OUT_SP + ((((size_t)l * BATCH + b) * NH + hd) * HD) * HD + 32 * dq + cl;
#pragma unroll
    for (int i = 0; i < 16; ++i) so[(size_t)(32 * dkb + (i & 3) + 8 * (i >> 2) + 4 * hh) * HD] = S[i];
}
__device__ __forceinline__ void ret_item_mfma(const Args& a, int l, int item, LAS unsigned char* lds, int tid) {
    const int b = item >> 7, c = (item >> 3) & 15, hd = item & 7, lane = tid & 63, w = __builtin_amdgcn_readfirstlane(tid >> 6), hh = lane >> 5, cl = lane & 31, ib = w & 3, dh = w >> 2;
    const size_t row0 = (size_t)b * SEQ + c * CH;
    LAS unsigned char* Qt = lds; LAS unsigned char* Kt = lds + T32K; LAS unsigned char* Vt = lds + 2 * T32K; LAS unsigned char* St = lds + 3 * T32K; LAS float* red = (LAS float*)(lds + 4 * T32K);
    __syncthreads();
    stage_tile(Qt, (const bf16*)(a.ws + WS_Q) + row0 * 1024 + 128 * hd, 1024, tid);
    stage_tile(Kt, (const bf16*)(a.ws + WS_K) + row0 * 1024 + 128 * hd, 1024, tid);
    stage_tile(Vt, (const bf16*)(a.ws + WS_V) + row0 * 1024 + 128 * hd, 1024, tid);
    stage_tile(St, (const bf16*)(a.ws + WS_ST) + ((((size_t)b * NCH + c) * NH + hd) * HD) * HD, 128, tid);
    __syncthreads();
    const size_t row = row0 + 32 * ib + cl;
    const bf16* Gg = (const bf16*)(a.ws + WS_SGR) + row * 1024 + 128 * hd + 64 * dh + 4 * hh;
    v2u gp[8];
#pragma unroll
    for (int g = 0; g < 4; ++g) { gp[g] = *(const v2u*)(Gg + 8 * g); gp[4 + g] = *(const v2u*)(Gg + 32 + 8 * g); }
    bf16x8 qf[8];
#pragma unroll
    for (int s = 0; s < 8; ++s) qf[s] = rowfrag(Qt, 32 * ib, lane, s);
    f32x16 o0, o1;
#pragma unroll
    for (int i = 0; i < 16; ++i) { o0[i] = 0.f; o1[i] = 0.f; }
    for (int jb = 0; jb <= ib; ++jb) {
        f32x16 X;
#pragma unroll
        for (int i = 0; i < 16; ++i) X[i] = 0.f;
#pragma unroll
        for (int s = 0; s < 8; ++s) X = MFMA32(rowfrag(Kt, 32 * jb, lane, s), qf[s], X);
        if (jb == ib) {
#pragma unroll
            for (int i = 0; i < 16; ++i) { const int jl = (i & 3) + 8 * (i >> 2) + 4 * hh; X[i] = jl <= cl ? X[i] : 0.f; }
        }
#pragma unroll
        for (int s2 = 0; s2 < 2; ++s2) { const bf16x8 xb = packx(X, s2);
            o0 = MFMA32(trfrag<true>(Vt, 32 * jb, lane, 2 * dh + 0, s2), xb, o0);
            o1 = MFMA32(trfrag<true>(Vt, 32 * jb, lane, 2 * dh + 1, s2), xb, o1); }
    }
#pragma unroll
    for (int s = 0; s < 8; ++s) { o0 = MFMA32(rowfrag(St, 32 * (2 * dh + 0), lane, s), qf[s], o0); o1 = MFMA32(rowfrag(St, 32 * (2 * dh + 1), lane, s), qf[s], o1); }
    float ssq = 0.f;
#pragma unroll
    for (int i = 0; i < 16; ++i) ssq += o0[i] * o0[i] + o1[i] * o1[i];
    ssq += __shfl_xor(ssq, 32);
    if (lane < 32) red[w * 32 + lane] = ssq;
    __syncthreads();
    const float rs = rsqrtf((red[ib * 32 + cl] + red[(ib + 4) * 32 + cl]) * (1.0f / 128.0f) + EPS);
    bf16* cat = (bf16*)(a.ws + WS_CAT) + row * 2048 + 128 * hd + 64 * dh + 4 * hh;
#pragma unroll
    for (int g = 0; g < 4; ++g) {
        const v2u g0 = gp[g], g1 = gp[4 + g]; v2u w0, w1;
        w0.x = pkbf(o0[4 * g] * rs * bflo(g0.x), o0[4 * g + 1] * rs * bfhi(g0.x)); w0.y = pkbf(o0[4 * g + 2] * rs * bflo(g0.y), o0[4 * g + 3] * rs * bfhi(g0.y));
        w1.x = pkbf(o1[4 * g] * rs * bflo(g1.x), o1[4 * g + 1] * rs * bfhi(g1.x)); w1.y = pkbf(o1[4 * g + 2] * rs * bflo(g1.y), o1[4 * g + 3] * rs * bfhi(g1.y));
        *(v2u*)(cat + 8 * g) = w0; *(v2u*)(cat + 32 + 8 * g) = w1; }
}
__device__ __forceinline__ void gm_item_mfma(const Args& a, int l, int item, LAS unsigned char* lds, int tid) {
    const int b = item >> 7, c = (item >> 3) & 15, hd = item & 7, lane = tid & 63, w = __builtin_amdgcn_readfirstlane(tid >> 6), hh = lane >> 5, cl = lane & 31, ib = w & 3, gh = w >> 2;
    const size_t row0 = (size_t)b * SEQ + c * CH;
    LAS unsigned char* VNt = lds; LAS unsigned char* Wt = lds + T32K; LAS float* ST2 = (LAS float*)(lds + 2 * T32K);
    __syncthreads();
    if (tid < 128) { const float* lp = (const float*)(a.ws + WS_LNS) + (row0 + tid) * 32; float s1 = 0.f, s2 = 0.f;
#pragma unroll
        for (int i = 0; i < 16; ++i) { s1 += lp[2 * i]; s2 += lp[2 * i + 1]; }
        const float mu = s1 * (1.0f / 1024.0f), var = s2 * (1.0f / 1024.0f) - mu * mu; ST2[2 * tid] = mu; ST2[2 * tid + 1] = rsqrtf(var + EPS); }
    stage_tile(Wt, (const bf16*)(a.ws + WS_WG) + ((size_t)l * NH + hd) * CH * CH, 128, tid);
    __syncthreads();
    { const bf16* vg = (const bf16*)(a.ws + WS_VG) + row0 * 1024 + 128 * hd; const float* lg = a.in[8] + l * 1024 + 128 * hd; const float* lb = a.in[9] + l * 1024 + 128 * hd;
#pragma unroll
      for (int i = 0; i < 4; ++i) { const int ch = tid + i * NTHR, r = ch >> 4, c0 = (ch & 15) * 8; const v4u x = *(const v4u*)(vg + (size_t)r * 1024 + c0);
          const float mu = ST2[2 * r], rstd = ST2[2 * r + 1]; const f32x4 g0 = *(const f32x4*)(lg + c0), g1 = *(const f32x4*)(lg + c0 + 4), b0 = *(const f32x4*)(lb + c0), b1 = *(const f32x4*)(lb + c0 + 4);
          v4u o; o.x = pkbf((bflo(x.x) - mu) * rstd * g0.x + b0.x, (bfhi(x.x) - mu) * rstd * g0.y + b0.y); o.y = pkbf((bflo(x.y) - mu) * rstd * g0.z + b0.z, (bfhi(x.y) - mu) * rstd * g0.w + b0.w);
          o.z = pkbf((bflo(x.z) - mu) * rstd * g1.x + b1.x, (bfhi(x.z) - mu) * rstd * g1.y + b1.y); o.w = pkbf((bflo(x.w) - mu) * rstd * g1.z + b1.z, (bfhi(x.w) - mu) * rstd * g1.w + b1.w);
          *(LAS v4u*)(VNt + offb(r, ch & 15)) = o; } }
    __syncthreads();
    const float bi = a.in[7][((size_t)l * NH + hd) * CH + 32 * ib + cl];
    const size_t row = row0 + 32 * ib + cl;
    const bf16* Ug = (const bf16*)(a.ws + WS_UG) + row * 1024 + 128 * hd + 64 * gh + 4 * hh;
    v2u gp[8];
#pragma unroll
    for (int g = 0; g < 4; ++g) { gp[g] = *(const v2u*)(Ug + 8 * g); gp[4 + g] = *(const v2u*)(Ug + 32 + 8 * g); }
    f32x16 s0, s1;
#pragma unroll
    for (int i = 0; i < 16; ++i) { s0[i] = 0.f; s1[i] = 0.f; }
    for (int ks = 0; ks < 2 * (ib + 1); ++ks) { const bf16x8 B = rowfrag(Wt, 32 * ib, lane, ks);
        s0 = MFMA32(trfrag<false>(VNt, 0, lane, 2 * gh + 0, ks), B, s0); s1 = MFMA32(trfrag<false>(VNt, 0, lane, 2 * gh + 1, ks), B, s1); }
    bf16* cat = (bf16*)(a.ws + WS_CAT) + row * 2048 + 1024 + 128 * hd + 64 * gh + 4 * hh;
#pragma unroll
    for (int g = 0; g < 4; ++g) {
        const v2u g0 = gp[g], g1 = gp[4 + g]; v2u w0, w1;
        w0.x = pkbf((s0[4 * g] + bi) * bflo(g0.x), (s0[4 * g + 1] + bi) * bfhi(g0.x)); w0.y = pkbf((s0[4 * g + 2] + bi) * bflo(g0.y), (s0[4 * g + 3] + bi) * bfhi(g0.y));
        w1.x = pkbf((s1[4 * g] + bi) * bflo(g1.x), (s1[4 * g + 1] + bi) * bfhi(g1.x)); w1.y = pkbf((s1[4 * g + 2] + bi) * bflo(g1.y), (s1[4 * g + 3] + bi) * bfhi(g1.y));
        *(v2u*)(cat + 8 * g) = w0; *(v2u*)(cat + 32 + 8 * g) = w1; }
}

constexpr int NPHASE = 10;
__global__ void __launch_bounds__(NTHR, 2) fwd_kernel(Args args) {
    extern __shared__ __attribute__((aligned(16))) unsigned char lds_raw[];
    LAS unsigned char* lds = (LAS unsigned char*)lds_raw;
    volatile LAS unsigned* MISC = (volatile LAS unsigned*)(lds + MISC_OFF);
    const int G = gridDim.x, bx = blockIdx.x, NGW = G * NWAVES;
    if (threadIdx.x < 128) MISC[threadIdx.x] = 0u;
#define PHASE_IDS() int tid = threadIdx.x; asm volatile("" : "+v"(tid)); const int lane = tid & 63, wave = __builtin_amdgcn_readfirstlane(tid >> 6), gw = bx * NWAVES + wave; (void)lane; (void)gw
    __syncthreads();
#if MK_PER_PHASE
#define GRID_BAR() do { } while (0)
#else
    XcdBarrier bar = xcd_barrier_post((unsigned*)(args.ws + WS_CTL) + 1024, MISC + 8);
#define GRID_BAR() xcd_barrier(bar)
#endif
    const int lo = args.ph_lo, hi = args.ph_hi;
#define IN(k) (lo <= (k) && (k) < hi)
#define SEAM(k) do { if (IN(k) && IN((k) + 1)) GRID_BAR(); } while (0)
#ifndef REPEAT_MASK
#define REPEAT_MASK 0
#endif
#define NREP(k) (((REPEAT_MASK >> (k)) & 1) ? 2 : 1)

    if (IN(0)) { PHASE_IDS(); const Args a = fresh_args(); p0_prologue(a, lds, gw, NGW, lane, wave); }
    SEAM(0);
    for (int l = 0; l < DEPTH; ++l) {
        const int p = 1 + 4 * l;
        if (IN(p)) {
            const Args a = fresh_args();
            pg8::Gemm g{(const bf16*)(a.ws + WS_XB), (const bf16*)(a.ws + WS_WT1) + (size_t)l * NIN * DM, MPAD, NIN, DM};
            pg8::StaticOrder S; S.init(MPAD, NIN, G, bx);
            EpiProj E{a.ws};
            pg8::gemm_phase<EpiProj, pg8::StaticOrder, true, true>(lds + RING_OFF, g, S, E);
        }
        SEAM(p);
        if (IN(p + 1)) for (int rep = 0; rep < NREP(p + 1); ++rep) {
            if (rep) GRID_BAR();
            PHASE_IDS(); const Args a = fresh_args();
            if (wave < 4) { for (int it = bx; it < BATCH * NH * 4; it += G) kvscan_wave(a, l, it, wave, lds + wave * 16384, lane); }
            else { for (int it = bx * 4 + wave - 4; it < DECB * NH; it += 4 * G) sample_ret_item(a, l, it, lane);
                   for (int it = bx * 4 + wave - 4; it < DECB; it += 4 * G) sample_gm_item(a, l, it, lane); }
        }
        SEAM(p + 1);
        if (IN(p + 2)) for (int rep = 0; rep < NREP(p + 2); ++rep) {
            if (rep) GRID_BAR();
            PHASE_IDS(); const Args a = fresh_args();
            for (int it = bx; it < BATCH * NCH * NH; it += G) ret_item_mfma(a, l, it, lds, tid);
            for (int it = bx; it < BATCH * NCH * NH; it += G) gm_item_mfma(a, l, it, lds, tid);
            __syncthreads();
        }
        SEAM(p + 2);
        if (IN(p + 3)) {
            const Args a = fresh_args();
            pg8::Gemm g{(const bf16*)(a.ws + WS_CAT), (const bf16*)(a.ws + WS_WT2) + (size_t)l * DM * MIXW, MPAD, DM, MIXW};
            pg8::StaticOrder S; S.init(MPAD, DM, G, bx);
            EpiRes E{l == 0 ? a.in[0] : (const float*)(a.ws + WS_H32), l == 0 ? a.in[1] : (const float*)(a.ws + WS_H32) + (size_t)MP * DM,
                     l == 0 ? (float*)(a.ws + WS_H32) : a.out + OUT_Y, a.ws};
            pg8::gemm_phase<EpiRes, pg8::StaticOrder, true, true>(lds + RING_OFF, g, S, E);
        }
        SEAM(p + 3);
    }
    if (IN(9)) {
        PHASE_IDS(); const Args a = fresh_args();
        for (int m = gw; m < MT; m += NGW) {
            const float* rp = (const float*)(a.ws + WS_RS) + (size_t)m * 16; float ssq = 0.f;
#pragma unroll
            for (int i = 0; i < 16; ++i) ssq += rp[i];
            const float rr = rsqrtf(ssq * (1.0f / 1024.0f) + EPS);
            f32x4* yr = (f32x4*)(a.out + OUT_Y + (size_t)m * DM) + lane; const f32x4* fg = (const f32x4*)a.in[10] + lane;
#pragma unroll
            for (int j = 0; j < 4; ++j) yr[64 * j] = yr[64 * j] * rr * fg[64 * j];
        }
    }
#undef IN
#undef SEAM
}

extern "C" void kernel_launch(void* const* d_in, const int* in_sizes, int n_in, void* d_out, int out_size, void* d_ws, size_t ws_size, hipStream_t stream) {
    static int grid = 0;
    if (grid == 0) {
        int dev = 0, cus = 0;
        if (n_in != 11 || ws_size < WS_END) { fprintf(stderr, "kernel_launch: unexpected n_in %d / ws_size %zu\n", n_in, ws_size); grid = -1; return; }
        if (hipGetDevice(&dev) != hipSuccess || hipDeviceGetAttribute(&cus, hipDeviceAttributeMultiprocessorCount, dev) != hipSuccess) { grid = -1; return; }
        if (hipFuncSetAttribute((const void*)fwd_kernel, hipFuncAttributeMaxDynamicSharedMemorySize, LDS_BYTES) != hipSuccess) { grid = -1; return; }
        (void)hipGetLastError();
        grid = cus;
    }
    if (grid < 0) return;
    (void)hipMemsetAsync((char*)d_ws + WS_CTL, 0, CTL_ZERO_BYTES, stream);
    Args a{};
    for (int i = 0; i < 11; ++i) a.in[i] = (const float*)d_in[i];
    a.out = (float*)d_out; a.ws = (unsigned char*)d_ws;
#if MK_PER_PHASE
    for (int p = 0; p < NPHASE; ++p) { a.ph_lo = p; a.ph_hi = p + 1; hipLaunchKernelGGL(fwd_kernel, dim3(grid), dim3(NTHR), LDS_BYTES, stream, a); }
#else
    a.ph_lo = 0; a.ph_hi = NPHASE; hipLaunchKernelGGL(fwd_kernel, dim3(grid), dim3(NTHR), LDS_BYTES, stream, a);
#endif
}
```

```cpp
#include <hip/hip_runtime.h>
#include <cstdio>
#include <cstdint>

#ifndef MK_PER_PHASE
#define MK_PER_PHASE 0
#endif

namespace pg8 {
#define PG8_LAS __attribute__((address_space(3)))
typedef unsigned short bf16_t;
typedef short bf16x8 __attribute__((ext_vector_type(8)));
typedef float f32x4 __attribute__((ext_vector_type(4)));
typedef unsigned u32x4 __attribute__((ext_vector_type(4)));
typedef unsigned u32x2 __attribute__((ext_vector_type(2)));
constexpr int BM = 256, BK = 64, HALF = 128, HTB = HALF * BK * 2  , STAGE_BYTES = 8 * HTB, NXCD = 8, WGM = 8;

__host__ __device__ __forceinline__ int lds_byte(int r, int c) { const int st = (r >> 4) * 2 + (c >> 5), rr = r & 15, cc = c & 31, ob = rr * 64 + cc * 2; return st * 1024 + (ob ^ (((ob >> 9) & 1) << 5)); }
__host__ __device__ __forceinline__ void stage_rc(int b, int& R, int& C) { const int st = b / 1024, sb = b % 1024, swz = sb ^ (((sb >> 9) & 1) << 5); R = (st >> 1) * 16 + swz / 64; C = (st & 1) * 32 + (swz % 64) / 2; }
__host__ __device__ __forceinline__ int perm32(int rho) { const int n = rho >> 4, i = rho & 15; return 8 * (i >> 2) + 4 * n + (i & 3); }

struct Unit { int pm, pn; };
struct Gemm { const bf16_t* A; const bf16_t* Bt; int M, N, K; };

struct StaticOrder {
    int nM, nN, nwg, G, c;
    __host__ __device__ void init(int M, int N, int G_, int c_) { nM = M / BM; nN = N / BM; nwg = nM * nN; G = G_; c = c_; }
    __host__ __device__ bool next(int i, Unit& u) const {
        const long L = (long)i * G + c; if (L >= nwg) return false;
        int wgid = (int)L; { const int q = nwg / NXCD, r = nwg % NXCD, xcd = wgid % NXCD, off = wgid / NXCD; wgid = (xcd < r ? xcd * (q + 1) : r * (q + 1) + (xcd - r) * q) + off; }
        const int nig = WGM * nN, gid = wgid / nig, fm = gid * WGM, gsz = (nM - fm) < WGM ? (nM - fm) : WGM;
        u.pm = fm + ((wgid % nig) % gsz); u.pn = (wgid % nig) / gsz; return true;
    }
    __device__ __forceinline__ void a_ready(const Unit&) const {}
    __device__ __forceinline__ void done(const Unit&) const {}
};

__device__ __forceinline__ unsigned cvt_pk_bf16(float lo, float hi) { unsigned r; asm volatile("v_cvt_pk_bf16_f32 %0, %1, %2" : "=v"(r) : "v"(lo), "v"(hi)); return r; }

template <class Epi, class Sched, bool ALIGN_EPI = false, bool SP2 = false>
__device__ __forceinline__ void gemm_phase(PG8_LAS unsigned char* lds, const Gemm g, const Sched& S, const Epi& E) {
    int tid_ = threadIdx.x; asm volatile("" : "+v"(tid_));
    const int tid = tid_, wid = __builtin_amdgcn_readfirstlane(tid >> 6), lane = tid & 63, wr = wid >> 2, wc = wid & 3, fr = lane & 15, fq = lane >> 4;
    const int K = g.K, nt = K / BK;
    unsigned voffA[2], voffB[2];
#pragma unroll
    for (int i = 0; i < 2; ++i) { int R, C; stage_rc(tid * 16 + i * 8192, R, C); const int Rb = Epi::PERM ? ((R & ~31) + perm32(R & 31)) : R;
        voffA[i] = (unsigned)(R * K + C) * 2u; voffB[i] = (unsigned)(Rb * K + C) * 2u; }
    const size_t kstep = (size_t)(BK * 2);
    const size_t hstep = (size_t)HALF * K * 2;
    const size_t tstep = 2 * hstep;
    const unsigned ldsw = (unsigned)wid * 1024u;
    const int aoff = lds_byte(wr * 64 + fr, fq * 8), boff = lds_byte(wc * 32 + fr, fq * 8);
#define PG8_SA(b, h) (((b) * 2 + (h)) * HTB)
#define PG8_SB(b, h) ((4 + (b) * 2 + (h)) * HTB)
#define PG8_STAGE(bufoff, gbase, voff) do { _Pragma("unroll") for (int _i = 0; _i < 2; ++_i) \
        __builtin_amdgcn_global_load_lds((const unsigned*)((const char*)(gbase) + (voff)[_i]), (PG8_LAS unsigned*)(lds + (bufoff) + ldsw + _i * 8192), 16, 0, 0); } while (0)
#define PG8_LDA(dst, b, h) do { _Pragma("unroll") for (int m = 0; m < 4; ++m) _Pragma("unroll") for (int k = 0; k < 2; ++k) dst[m][k] = *(const PG8_LAS bf16x8*)(lds + PG8_SA(b, h) + aoff + m * 2048 + k * 1024); } while (0)
#define PG8_LDB(dst, b, h) do { _Pragma("unroll") for (int n = 0; n < 2; ++n) _Pragma("unroll") for (int k = 0; k < 2; ++k) dst[n][k] = *(const PG8_LAS bf16x8*)(lds + PG8_SB(b, h) + boff + n * 2048 + k * 1024); } while (0)
#define PG8_MMA(ai, bj, At, Bt) do { __builtin_amdgcn_s_setprio(1); _Pragma("unroll") for (int m = 0; m < 4; ++m) _Pragma("unroll") for (int n = 0; n < 2; ++n) _Pragma("unroll") for (int k = 0; k < 2; ++k) \
        acc[ai][bj][m][n] = __builtin_amdgcn_mfma_f32_16x16x32_bf16(Bt[n][k], At[m][k], acc[ai][bj][m][n], 0, 0, 0); __builtin_amdgcn_s_setprio(0); } while (0)
#define PG8_WAIT_V(n) asm volatile("s_waitcnt vmcnt(" #n ")" ::: "memory")
#define PG8_WAIT_L(n) asm volatile("s_waitcnt lgkmcnt(" #n ")" ::: "memory")
#define PG8_BAR __builtin_amdgcn_s_barrier()
#define PG8_SCHED __builtin_amdgcn_sched_barrier(0)
    Unit cur, nxt; int ui = 0;
    if (!S.next(0, cur)) return;
    f32x4 acc[2][2][4][2];
#pragma unroll
    for (int a = 0; a < 2; ++a)
#pragma unroll
        for (int b = 0; b < 2; ++b)
#pragma unroll
            for (int m = 0; m < 4; ++m)
#pragma unroll
                for (int n = 0; n < 2; ++n) acc[a][b][m][n] = (f32x4){0.f, 0.f, 0.f, 0.f};
    bf16x8 At[4][2], B0[2][2], B1[2][2];
    const char* cA = (const char*)g.A + (size_t)cur.pm * tstep; const char* cB = (const char*)g.Bt + (size_t)cur.pn * tstep;
    S.a_ready(cur);
    if constexpr (SP2) {
        PG8_STAGE(PG8_SB(0, 0), cB, voffB); PG8_STAGE(PG8_SB(0, 1), cB + hstep, voffB); PG8_STAGE(PG8_SA(0, 0), cA, voffA); PG8_STAGE(PG8_SA(0, 1), cA + hstep, voffA);
        if (wr == 1) PG8_BAR;
        PG8_WAIT_V(2); PG8_BAR;
        PG8_STAGE(PG8_SB(1, 0), cB + kstep, voffB); PG8_STAGE(PG8_SA(1, 0), cA + kstep, voffA); PG8_STAGE(PG8_SB(1, 1), cB + hstep + kstep, voffB);
        PG8_WAIT_V(6); PG8_BAR;
    } else {
        PG8_STAGE(PG8_SB(0, 0), cB, voffB); PG8_STAGE(PG8_SA(0, 0), cA, voffA); PG8_STAGE(PG8_SB(0, 1), cB + hstep, voffB); PG8_STAGE(PG8_SA(0, 1), cA + hstep, voffA);
        if (wr == 1) PG8_BAR;
        PG8_WAIT_V(4); PG8_BAR;
        PG8_STAGE(PG8_SB(1, 0), cB + kstep, voffB); PG8_STAGE(PG8_SA(1, 0), cA + kstep, voffA); PG8_STAGE(PG8_SB(1, 1), cB + hstep + kstep, voffB);
        PG8_WAIT_V(6); PG8_BAR;
    }
    for (;;) {
        const bool has_next = S.next(ui + 1, nxt);
        const char* nA = has_next ? (const char*)g.A + (size_t)nxt.pm * tstep : cA; const char* nB = has_next ? (const char*)g.Bt + (size_t)nxt.pn * tstep : cB;
        for (int t = 0; t < nt; t += 2) {
            const bool last = (t == nt - 2);
            const char* a1 = cA + (size_t)(t + 1) * kstep;
            const char* a2 = last ? nA : cA + (size_t)(t + 2) * kstep; const char* b2 = last ? nB : cB + (size_t)(t + 2) * kstep;
            const char* a3 = a2 + kstep; const char* b3 = b2 + kstep;
            if (last && has_next) S.a_ready(nxt);
            if constexpr (SP2) {
            PG8_LDB(B0, 0, 0); PG8_LDB(B1, 0, 1); PG8_SCHED; PG8_LDA(At, 0, 0); PG8_STAGE(PG8_SA(1, 1), a1 + hstep, voffA);
            PG8_WAIT_V(8); PG8_WAIT_L(0); PG8_BAR; PG8_MMA(0, 0, At, B0); PG8_MMA(0, 1, At, B1); PG8_BAR; PG8_SCHED;
            PG8_LDA(At, 0, 1); PG8_STAGE(PG8_SB(0, 0), b2, voffB); PG8_STAGE(PG8_SB(0, 1), b2 + hstep, voffB); PG8_STAGE(PG8_SA(0, 0), a2, voffA);
            PG8_WAIT_V(8); PG8_WAIT_L(0); PG8_BAR; PG8_MMA(1, 0, At, B0); PG8_MMA(1, 1, At, B1); PG8_BAR; PG8_SCHED;
            PG8_LDB(B0, 1, 0); PG8_LDB(B1, 1, 1); PG8_SCHED; PG8_LDA(At, 1, 0); PG8_STAGE(PG8_SA(0, 1), a2 + hstep, voffA);
            PG8_WAIT_V(8); PG8_WAIT_L(0); PG8_BAR; PG8_MMA(0, 0, At, B0); PG8_MMA(0, 1, At, B1); PG8_BAR; PG8_SCHED;
            PG8_LDA(At, 1, 1); PG8_STAGE(PG8_SB(1, 0), b3, voffB); PG8_STAGE(PG8_SB(1, 1), b3 + hstep, voffB); PG8_STAGE(PG8_SA(1, 0), a3, voffA);
            PG8_WAIT_V(8); PG8_WAIT_L(0); PG8_BAR; PG8_MMA(1, 0, At, B0); PG8_MMA(1, 1, At, B1); PG8_BAR; PG8_SCHED;
            } else {
            PG8_LDB(B0, 0, 0); PG8_SCHED; PG8_LDA(At, 0, 0); PG8_STAGE(PG8_SA(1, 1), a1 + hstep, voffA);
            PG8_WAIT_L(8); PG8_BAR; PG8_WAIT_L(0); PG8_MMA(0, 0, At, B0); PG8_BAR; PG8_SCHED;
            PG8_LDB(B1, 0, 1); PG8_STAGE(PG8_SB(0, 0), b2, voffB);
            PG8_BAR; PG8_WAIT_L(0); PG8_MMA(0, 1, At, B1); PG8_BAR;
            PG8_LDA(At, 0, 1); PG8_STAGE(PG8_SA(0, 0), a2, voffA);
            PG8_BAR; PG8_WAIT_L(0); PG8_MMA(1, 0, At, B0); PG8_BAR; PG8_SCHED;
            PG8_STAGE(PG8_SB(0, 1), b2 + hstep, voffB);
            PG8_WAIT_V(6); PG8_BAR; PG8_MMA(1, 1, At, B1); PG8_BAR;
            PG8_LDB(B0, 1, 0); PG8_SCHED; PG8_LDA(At, 1, 0); PG8_STAGE(PG8_SA(0, 1), a2 + hstep, voffA);
            PG8_WAIT_L(8); PG8_BAR; PG8_WAIT_L(0); PG8_MMA(0, 0, At, B0); PG8_BAR; PG8_SCHED;
            PG8_LDB(B1, 1, 1); PG8_STAGE(PG8_SB(1, 0), b3, voffB);
            PG8_BAR; PG8_WAIT_L(0); PG8_MMA(0, 1, At, B1); PG8_BAR;
            PG8_LDA(At, 1, 1); PG8_STAGE(PG8_SA(1, 0), a3, voffA);
            PG8_BAR; PG8_WAIT_L(0); PG8_MMA(1, 0, At, B0); PG8_BAR; PG8_SCHED;
            PG8_STAGE(PG8_SB(1, 1), b3 + hstep, voffB);
            PG8_WAIT_V(6); PG8_BAR; PG8_MMA(1, 1, At, B1); PG8_BAR;
            }
        }
        if constexpr (ALIGN_EPI) { if (wr == 0) PG8_BAR; }
        E(acc, cur, wr, wc, fr, fq); S.done(cur);
        if (!has_next) break;
#pragma unroll
        for (int a = 0; a < 2; ++a)
#pragma unroll
            for (int b = 0; b < 2; ++b)
#pragma unroll
                for (int m = 0; m < 4; ++m)
#pragma unroll
                    for (int n = 0; n < 2; ++n) acc[a][b][m][n] = (f32x4){0.f, 0.f, 0.f, 0.f};
        cur = nxt; cA = nA; cB = nB; ++ui;
        if constexpr (ALIGN_EPI) { if (wr == 1) PG8_BAR; }
    }
    PG8_WAIT_V(0);
    if constexpr (!ALIGN_EPI) { if (wr == 0) PG8_BAR; }
    PG8_BAR;
#undef PG8_SA
#undef PG8_SB
#undef PG8_STAGE
#undef PG8_LDA
#undef PG8_LDB
#undef PG8_MMA
#undef PG8_WAIT_V
#undef PG8_WAIT_L
#undef PG8_BAR
#undef PG8_SCHED
}
}

constexpr int NWAVES = 8, NTHR = NWAVES * 64;
constexpr int DM = 1024, BATCH = 8, SEQ = 2048, DEPTH = 2, DECB = 128, PAST = 16384;
constexpr int MP = BATCH * SEQ;
constexpr int MT = MP + DECB;
constexpr int MPAD = 16640;
constexpr int NIN = 7168, MIXW = 2048, CH = 128, NH = 8, HD = 128, NCH = SEQ / CH;
constexpr float EPS = 1e-6f;

constexpr size_t MiB = 1u << 20;
constexpr size_t WS_CTL = 0, CTL_ZERO_BYTES = 64 * 1024;
constexpr size_t WS_WT1 = 1 * MiB;
constexpr size_t WS_WT2 = 29 * MiB;
constexpr size_t WS_WG  = 37 * MiB;
constexpr size_t WS_ROPE = 37 * MiB + 512 * 1024;
constexpr size_t WS_RS  = 39 * MiB;
constexpr size_t WS_RR = 40 * MiB;
constexpr size_t WS_LNS = 41 * MiB;
constexpr size_t WS_XB  = 44 * MiB;
constexpr size_t WS_H32 = 77 * MiB;
constexpr size_t PROJ_BYTES = (size_t)MPAD * 1024 * 2;
constexpr size_t WS_Q   = 142 * MiB;
constexpr size_t WS_K   = WS_Q + PROJ_BYTES;
constexpr size_t WS_V   = WS_K + PROJ_BYTES;
constexpr size_t WS_SGR = WS_V + PROJ_BYTES;
constexpr size_t WS_UG  = WS_SGR + PROJ_BYTES;
constexpr size_t WS_VG  = WS_UG + PROJ_BYTES;
constexpr size_t WS_CAT = 337 * MiB;
constexpr size_t WS_ST  = 402 * MiB;
constexpr size_t WS_END = 434 * MiB;
static_assert(WS_VG + PROJ_BYTES <= WS_CAT && WS_H32 + (size_t)MT * 1024 * 4 <= WS_Q && WS_XB + PROJ_BYTES <= WS_H32, "ws map");

constexpr size_t OUT_Y   = 0;
constexpr size_t OUT_SP  = (size_t)MT * 1024;
constexpr size_t OUT_SS  = OUT_SP + (size_t)DEPTH * BATCH * NH * HD * HD;
constexpr size_t OUT_GV  = OUT_SS + (size_t)DEPTH * DECB * NH * HD * HD;

constexpr int RING_OFF = 0, RING_BYTES = 131072;
constexpr int LDS_BYTES = 147456;
constexpr int MISC_OFF = LDS_BYTES - 512;

#define GAS __attribute__((address_space(1)))
#define LAS __attribute__((address_space(3)))
typedef unsigned short bf16;
typedef unsigned v4u __attribute__((ext_vector_type(4)));
typedef unsigned v2u __attribute__((ext_vector_type(2)));
typedef float f32x4 __attribute__((ext_vector_type(4)));
typedef float f32x2 __attribute__((ext_vector_type(2)));
#define LDS_WAIT() asm volatile("s_waitcnt lgkmcnt(0)" ::: "memory")
__device__ __forceinline__ unsigned f2bf(float f) { unsigned u = __builtin_bit_cast(unsigned, f); return (u + 0x7fffu + ((u >> 16) & 1u)) >> 16; }
__device__ __forceinline__ unsigned pk2(float lo, float hi) { return f2bf(lo) | (f2bf(hi) << 16); }
__device__ __forceinline__ float bf2f(unsigned b) { return __builtin_bit_cast(float, b << 16); }
__device__ __forceinline__ float bflo(unsigned w) { return __builtin_bit_cast(float, w << 16); }
__device__ __forceinline__ float bfhi(unsigned w) { return __builtin_bit_cast(float, w & 0xffff0000u); }
__device__ __forceinline__ float silu_f(float x) { return x / (1.0f + __expf(-x)); }
__device__ __forceinline__ float wave_sum(float v) {
#pragma unroll
    for (int o = 1; o < 64; o <<= 1) v += __shfl_xor(v, o);
    return v;
}
__device__ __forceinline__ float lg2gamma(int h) {
    return h == 0 ? -0.04580368961312479f : h == 1 ? -0.02272007650008353f : h == 2 ? -0.011315313227834146f : h == 3 ? -0.005646563141142063f :
           h == 4 ? -0.0028205190623786626f : h == 5 ? -0.0014095702546713536f : h == 6 ? -0.0007046129765893727f : -0.0003522634716290214f;
}

#define XB_TMO      128
#define XB_XCNT(j)  (256  + 64 * (j))
#define XB_XSUB(j)  (1280 + 64 * (j))
#define XB_XGEN(j)  (2304 + 64 * (j))
#define XB_TOP      3328
#define XB_TOPGEN   3392
#define XCD_BAR_WORDS 3456
#define XB_SPIN_CAP (1u << 18)
__device__ __forceinline__ unsigned xb_ld(unsigned* p)              { return __hip_atomic_load(p, __ATOMIC_RELAXED, __HIP_MEMORY_SCOPE_AGENT); }
__device__ __forceinline__ unsigned xb_add(unsigned* p, unsigned v) { return __hip_atomic_fetch_add(p, v, __ATOMIC_RELAXED, __HIP_MEMORY_SCOPE_AGENT); }
__device__ __forceinline__ unsigned xb_xcc_id() { return (unsigned)__builtin_amdgcn_s_getreg((3 << 11) | 20) & 0xFu; }
#define XB_SPIN(cond, bar) do { unsigned _sp = 0; while (cond) { __builtin_amdgcn_s_sleep(1); \
    if ((++_sp & 255u) == 0u) { if (xb_ld(&(bar)[XB_TMO])) break; if (_sp > XB_SPIN_CAP) { atomicAdd(&(bar)[XB_TMO], 1u); break; } } } } while (0)
struct XcdBarrier { unsigned* bar; unsigned x; volatile LAS unsigned* st; };
__device__ __forceinline__ XcdBarrier xcd_barrier_post(unsigned* bar, volatile LAS unsigned* st) {
    XcdBarrier b; b.bar = bar; b.x = xb_xcc_id(); b.st = st;
    if (threadIdx.x == 0) (void)xb_add(&bar[XB_XCNT(b.x)], 1u);
    return b;
}
__device__ __forceinline__ void xcd_barrier_complete(unsigned* bar, unsigned x, unsigned& nloc, unsigned& nx) {
    const unsigned G = gridDim.x * gridDim.y * gridDim.z;
    unsigned sum, cnt, mine, sp = 0u;
    for (;;) {
        sum = 0u; cnt = 0u; mine = 0u;
#pragma unroll
        for (unsigned j = 0; j < 16; ++j) { const unsigned c = xb_ld(&bar[XB_XCNT(j)]); sum += c; cnt += (c > 0u) ? 1u : 0u; mine = (j == x) ? c : mine; }
        if (sum == G) break;
        __builtin_amdgcn_s_sleep(1);
        if ((++sp & 255u) == 0u) { if (xb_ld(&bar[XB_TMO])) break; if (sp > XB_SPIN_CAP) { atomicAdd(&bar[XB_TMO], 1u); break; } }
    }
    nloc = mine > 0u ? mine : 1u; nx = cnt > 0u ? cnt : 1u;
}
__device__ __forceinline__ void xcd_barrier(const XcdBarrier& b) {
    asm volatile("s_waitcnt vmcnt(0)" ::: "memory");
    __syncthreads();
    if (threadIdx.x == 0) {
        unsigned* bar = b.bar;
        __builtin_amdgcn_s_waitcnt(0);
        unsigned nloc = b.st[0], nx = b.st[1];
        if (nloc == 0u) { xcd_barrier_complete(bar, b.x, nloc, nx); b.st[0] = nloc; b.st[1] = nx; }
        const unsigned old = xb_add(&bar[XB_XSUB(b.x)], 1u);
        const unsigned gen = old / nloc;
        if (old + 1u == (gen + 1u) * nloc) {
            __builtin_amdgcn_fence(__ATOMIC_RELEASE, "agent");
            asm volatile("s_waitcnt vmcnt(0)" ::: "memory");
            const unsigned og = xb_add(&bar[XB_TOP], 1u);
            const unsigned tg = og / nx;
            if (og + 1u == (tg + 1u) * nx) xb_add(&bar[XB_TOPGEN], 1u);
            else XB_SPIN(xb_ld(&bar[XB_TOPGEN]) == tg, bar);
            __builtin_amdgcn_fence(__ATOMIC_ACQUIRE, "agent");
            xb_add(&bar[XB_XGEN(b.x)], 1u);
            asm volatile("s_waitcnt vmcnt(0)" ::: "memory");
        } else {
            XB_SPIN(xb_ld(&bar[XB_XGEN(b.x)]) == gen, bar);
            __builtin_amdgcn_fence(__ATOMIC_ACQUIRE, "agent");
            asm volatile("s_waitcnt vmcnt(0)" ::: "memory");
        }
    }
    __syncthreads();
}

struct EpiProj {
    static constexpr bool PERM = true;
    unsigned char* ws; const float* RR;
    __device__ __forceinline__ void operator()(const pg8::f32x4 (&acc)[2][2][4][2], const pg8::Unit& u, int wr, int wc, int fr, int fq) const {
        bf16* const Q = (bf16*)(ws + WS_Q); bf16* const K = (bf16*)(ws + WS_K); bf16* const V = (bf16*)(ws + WS_V); bf16* const SGR = (bf16*)(ws + WS_SGR);
        bf16* const UG = (bf16*)(ws + WS_UG); bf16* const VG = (bf16*)(ws + WS_VG); float* const LNS = (float*)(ws + WS_LNS);
        const float* const rope = (const float*)(ws + WS_ROPE);
        const int pn = u.pn, rowb = u.pm * 256 + wr * 64 + fr;
        float rrv[8];
#pragma unroll
        for (int it = 0; it < 8; ++it) rrv[it] = RR[rowb + (it >> 2) * 128 + (it & 3) * 16];
        if (pn < 8) {
            const int head = 2 * (pn & 3) + (wc >> 1), f0 = 32 * (wc & 1) + 8 * fq;
            const float lg = lg2gamma(head); bf16* const dstb = (pn < 4 ? Q : K) + 128 * head + f0;
            f32x4 cc[4], cn[4];
            { const f32x4* cs = (const f32x4*)(rope + ((size_t)(rowb & (SEQ - 1)) * 64 + f0) * 2);
#pragma unroll
              for (int t = 0; t < 4; ++t) cc[t] = cs[t]; }
#pragma unroll
            for (int it = 0; it < 8; ++it) {
                const int ai = it >> 2, m = it & 3, row = rowb + ai * 128 + m * 16;
                if (it < 7) { const int rown = rowb + ((it + 1) >> 2) * 128 + ((it + 1) & 3) * 16; const f32x4* cs = (const f32x4*)(rope + ((size_t)(rown & (SEQ - 1)) * 64 + f0) * 2);
#pragma unroll
                    for (int t = 0; t < 4; ++t) cn[t] = cs[t]; }
                const float rr = rsqrtf(rrv[it] * (1.0f / 1024.0f) + EPS);
                const float e = lg * (float)((row & (CH - 1)) + 1);
                const float sc = rr * (pn < 4 ? exp2f(e) : exp2f(-e) * 0.08838834764831845f);
                float o1[8], o2[8];
#pragma unroll
                for (int t = 0; t < 4; ++t) { const f32x4 c4 = cc[t];
                    const int e0 = 2 * t, e1 = 2 * t + 1;
                    const float a0 = acc[ai][0][m][e0 >> 2][e0 & 3], b0 = acc[ai][1][m][e0 >> 2][e0 & 3];
                    const float a1 = acc[ai][0][m][e1 >> 2][e1 & 3], b1 = acc[ai][1][m][e1 >> 2][e1 & 3];
                    o1[e0] = (a0 * c4.x - b0 * c4.y) * sc; o2[e0] = (a0 * c4.y + b0 * c4.x) * sc;
                    o1[e1] = (a1 * c4.z - b1 * c4.w) * sc; o2[e1] = (a1 * c4.w + b1 * c4.z) * sc; }
                bf16* dst = dstb + (size_t)row * 1024;
                pg8::u32x4 w1, w2;
                w1.x = pg8::cvt_pk_bf16(o1[0], o1[1]); w1.y = pg8::cvt_pk_bf16(o1[2], o1[3]); w1.z = pg8::cvt_pk_bf16(o1[4], o1[5]); w1.w = pg8::cvt_pk_bf16(o1[6], o1[7]);
                w2.x = pg8::cvt_pk_bf16(o2[0], o2[1]); w2.y = pg8::cvt_pk_bf16(o2[2], o2[3]); w2.z = pg8::cvt_pk_bf16(o2[4], o2[5]); w2.w = pg8::cvt_pk_bf16(o2[6], o2[7]);
                *(pg8::u32x4*)dst = w1; *(pg8::u32x4*)(dst + 64) = w2;
#pragma unroll
                for (int t = 0; t < 4; ++t) cc[t] = cn[t];
            }
            return;
        }
#pragma unroll
        for (int ai = 0; ai < 2; ++ai)
#pragma unroll
            for (int m = 0; m < 4; ++m) {
                const int row = rowb + ai * 128 + m * 16;
                const float rr = rsqrtf(rrv[ai * 4 + m] * (1.0f / 1024.0f) + EPS);
                if (pn < 16) {
                    const bool isv = pn < 12;
                    bf16* dst = (isv ? V : SGR) + (size_t)row * 1024 + 256 * (isv ? pn - 8 : pn - 12) + 32 * wc + 8 * fq;
#pragma unroll
                    for (int bj = 0; bj < 2; ++bj) { f32x4 v0 = acc[ai][bj][m][0] * rr, v1 = acc[ai][bj][m][1] * rr;
                        if (!isv) {
#pragma unroll
                            for (int j = 0; j < 4; ++j) { v0[j] = silu_f(v0[j]); v1[j] = silu_f(v1[j]); } }
                        pg8::u32x4 w; w.x = pg8::cvt_pk_bf16(v0[0], v0[1]); w.y = pg8::cvt_pk_bf16(v0[2], v0[3]); w.z = pg8::cvt_pk_bf16(v1[0], v1[1]); w.w = pg8::cvt_pk_bf16(v1[2], v1[3]);
                        *(pg8::u32x4*)(dst + 128 * bj) = w; }
                } else if (pn < 24) {
                    bf16* dst = UG + (size_t)row * 1024 + 128 * (pn - 16) + 32 * wc + 8 * fq;
                    f32x4 v0 = acc[ai][0][m][0] * rr, v1 = acc[ai][0][m][1] * rr; const f32x4 g0 = acc[ai][1][m][0] * rr, g1 = acc[ai][1][m][1] * rr;
#pragma unroll
                    for (int j = 0; j < 4; ++j) { v0[j] *= silu_f(g0[j]); v1[j] *= silu_f(g1[j]); }
                    pg8::u32x4 w; w.x = pg8::cvt_pk_bf16(v0[0], v0[1]); w.y = pg8::cvt_pk_bf16(v0[2], v0[3]); w.z = pg8::cvt_pk_bf16(v1[0], v1[1]); w.w = pg8::cvt_pk_bf16(v1[2], v1[3]);
                    *(pg8::u32x4*)dst = w;
                } else {
                    bf16* dst = VG + (size_t)row * 1024 + 256 * (pn - 24) + 32 * wc + 8 * fq;
                    float s1 = 0.f, s2 = 0.f;
#pragma unroll
                    for (int bj = 0; bj < 2; ++bj) { const f32x4 v0 = acc[ai][bj][m][0] * rr, v1 = acc[ai][bj][m][1] * rr;
#pragma unroll
                        for (int j = 0; j < 4; ++j) { s1 += v0[j] + v1[j]; s2 += v0[j] * v0[j] + v1[j] * v1[j]; }
                        pg8::u32x4 w; w.x = pg8::cvt_pk_bf16(v0[0], v0[1]); w.y = pg8::cvt_pk_bf16(v0[2], v0[3]); w.z = pg8::cvt_pk_bf16(v1[0], v1[1]); w.w = pg8::cvt_pk_bf16(v1[2], v1[3]);
                        *(pg8::u32x4*)(dst + 128 * bj) = w; }
                    s1 += __shfl_xor(s1, 16); s1 += __shfl_xor(s1, 32); s2 += __shfl_xor(s2, 16); s2 += __shfl_xor(s2, 32);
                    if (fq == 0) *(f32x2*)(LNS + ((size_t)row * 16 + (pn - 24) * 4 + wc) * 2) = (f32x2){s1, s2};
                }
            }
    }
};
struct EpiRes {
    static constexpr bool PERM = false;
    const float* res_p; float* out; unsigned char* ws; float* RRn;
    __device__ __forceinline__ void operator()(const pg8::f32x4 (&acc)[2][2][4][2], const pg8::Unit& u, int wr, int wc, int fr, int fq) const {
        bf16* const XB = (bf16*)(ws + WS_XB);
        const int rowb = u.pm * 256 + wr * 64 + fr, colb = u.pn * 256 + wc * 32 + 4 * fq;
        f32x4 rc[4], rn[4];
        { const float* rsrc = res_p + (size_t)rowb * 1024 + colb;
#pragma unroll
          for (int q = 0; q < 4; ++q) rc[q] = *(const f32x4*)(rsrc + (q >> 1) * 128 + (q & 1) * 16); }
#pragma unroll
        for (int it = 0; it < 8; ++it) {
            const int ai = it >> 2, m = it & 3, row = rowb + ai * 128 + m * 16;
            if (it < 7) { const float* rsrc = res_p + (size_t)(rowb + ((it + 1) >> 2) * 128 + ((it + 1) & 3) * 16) * 1024 + colb;
#pragma unroll
                for (int q = 0; q < 4; ++q) rn[q] = *(const f32x4*)(rsrc + (q >> 1) * 128 + (q & 1) * 16); }
            float ssq = 0.f;
            float* o = out + (size_t)row * 1024 + colb; bf16* xb = XB + (size_t)row * 1024 + colb;
#pragma unroll
            for (int q = 0; q < 4; ++q) { const int bj = q >> 1, n = q & 1; const f32x4 hn = rc[q] + acc[ai][bj][m][n];
                *(f32x4*)(o + bj * 128 + n * 16) = hn; ssq += (hn.x * hn.x + hn.y * hn.y) + (hn.z * hn.z + hn.w * hn.w);
                pg8::u32x2 w; w.x = pg8::cvt_pk_bf16(hn.x, hn.y); w.y = pg8::cvt_pk_bf16(hn.z, hn.w); *(pg8::u32x2*)(xb + bj * 128 + n * 16) = w; }
            ssq += __shfl_xor(ssq, 16); ssq += __shfl_xor(ssq, 32);
            if (fq == 0) atomicAdd(RRn + row, ssq);
#pragma unroll
            for (int q = 0; q < 4; ++q) rc[q] = rn[q];
        }
    }
};

struct Args { const float* in[11]; float* out; unsigned char* ws; int ph_lo, ph_hi; };

#define CAS __attribute__((address_space(4)))
__device__ __forceinline__ Args fresh_args() { const unsigned long long p0 = (unsigned long long)__builtin_amdgcn_kernarg_segment_ptr();
    unsigned plo = __builtin_amdgcn_readfirstlane((unsigned)p0), phi = __builtin_amdgcn_readfirstlane((unsigned)(p0 >> 32)); asm volatile("" : "+s"(plo), "+s"(phi));
    const CAS Args* q = (const CAS Args*)(((unsigned long long)phi << 32) | plo); Args r;
#pragma unroll
    for (int i = 0; i < 11; ++i) r.in[i] = q->in[i];
    r.out = q->out; r.ws = q->ws; r.ph_lo = q->ph_lo; r.ph_hi = q->ph_hi; return r; }
__device__ __forceinline__ int colmap(int np) {
    const int pn = np >> 8, tc = np & 255;
    if (pn < 8) { const int base = (pn < 4) ? 0 : 1024, head = 2 * (pn & 3) + ((tc & 127) >> 6), part = tc >> 7; return base + 128 * head + 64 * part + (tc & 63); }
    if (pn < 12) return 2048 + 256 * (pn - 8) + tc;
    if (pn < 16) return 3072 + 256 * (pn - 12) + tc;
    if (pn < 24) { const int head = pn - 16; return tc < 128 ? 4096 + 128 * head + tc : 6144 + 128 * head + (tc - 128); }
    return 5120 + 256 * (pn - 24) + tc;
}
__device__ __forceinline__ void p0_transpose_item(const float* W, int K, int N, bf16* WT, const float* gk, int k0, int src_n0, int dst_n0, LAS float* scr, int lane) {
#pragma unroll
    for (int i = 0; i < 32; ++i) { const int kk = 2 * i + (lane >> 5); float v = W[(size_t)(k0 + kk) * N + src_n0 + (lane & 31)]; if (gk) v *= gk[k0 + kk]; scr[kk * 33 + (lane & 31)] = v; }
    LDS_WAIT(); asm volatile("" ::: "memory");
    const int c = lane & 7;
#pragma unroll
    for (int j = 0; j < 4; ++j) { const int n = (lane >> 3) + 8 * j; const LAS float* s = scr + (8 * c) * 33 + n;
        v4u o; o.x = pk2(s[0 * 33], s[1 * 33]); o.y = pk2(s[2 * 33], s[3 * 33]); o.z = pk2(s[4 * 33], s[5 * 33]); o.w = pk2(s[6 * 33], s[7 * 33]);
        *(v4u*)(WT + (size_t)(dst_n0 + n) * K + k0 + 8 * c) = o; }
    LDS_WAIT(); asm volatile("" ::: "memory");
}
__device__ __forceinline__ void p0_prologue(const Args& a, LAS unsigned char* lds, int gw, int NGW, int lane, int wave) {
    LAS float* scr = (LAS float*)(lds + RING_OFF + wave * 16384);
    unsigned char* ws = a.ws;
    constexpr int I1 = (DM / 64) * (NIN / 32), I2 = (MIXW / 64) * (DM / 32), NITEMS = DEPTH * (I1 + I2);
    for (int it = gw; it < NITEMS; it += NGW) {
        const int l = it / (I1 + I2); int r = it % (I1 + I2);
        if (r < I1) { const int kb = r / (NIN / 32), nb = r % (NIN / 32);
            p0_transpose_item(a.in[4] + (size_t)l * DM * NIN, DM, NIN, (bf16*)(ws + WS_WT1) + (size_t)l * NIN * DM, a.in[3] + l * DM, 64 * kb, colmap(32 * nb), 32 * nb, scr, lane); }
        else { r -= I1; const int kb = r / (DM / 32), nb = r % (DM / 32);
            p0_transpose_item(a.in[5] + (size_t)l * MIXW * DM, MIXW, DM, (bf16*)(ws + WS_WT2) + (size_t)l * DM * MIXW, nullptr, 64 * kb, 32 * nb, 32 * nb, scr, lane); }
    }
    for (int m = 2 * gw; m < MT; m += 2 * NGW) {
        f32x4 v[2][4]; float sq[2];
#pragma unroll
        for (int r = 0; r < 2; ++r) { const int mm = m + r; const float* xrow = mm < MP ? a.in[0] + (size_t)mm * DM : a.in[1] + (size_t)(mm - MP) * DM; const f32x4* xr = (const f32x4*)xrow + lane;
#pragma unroll
            for (int j = 0; j < 4; ++j) v[r][j] = xr[64 * j]; }
#pragma unroll
        for (int r = 0; r < 2; ++r) { float s = 0.f;
#pragma unroll
            for (int j = 0; j < 4; ++j) s += (v[r][j].x * v[r][j].x + v[r][j].y * v[r][j].y) + (v[r][j].z * v[r][j].z + v[r][j].w * v[r][j].w);
            sq[r] = wave_sum(s); }
#pragma unroll
        for (int r = 0; r < 2; ++r) { const int mm = m + r;
            unsigned long long* o8 = (unsigned long long*)((bf16*)(ws + WS_XB) + (size_t)mm * DM) + lane;
#pragma unroll
            for (int j = 0; j < 4; ++j) o8[64 * j] = (unsigned long long)pk2(v[r][j].x, v[r][j].y) | ((unsigned long long)pk2(v[r][j].z, v[r][j].w) << 32);
            if (lane < 3) ((float*)(ws + WS_RR))[(size_t)lane * MPAD + mm] = lane == 0 ? sq[r] : 0.f; }
    }
    const int gt = gw * 64 + lane, NGT = NGW * 64;
    for (int i = gt; i < (SEQ + 1) * 64; i += NGT) {
        const int pidx = i >> 6, f = i & 63; const double pos = pidx < SEQ ? (double)pidx : (double)PAST;
        double inv = 1.0; for (int j = 0; j < f; ++j) inv *= 0.8659643233600653;
        const double ang = pos * inv; const double q = __builtin_rint(ang * 0.63661977236758134308);
        double r = __builtin_fma(-q, 1.5707963267948966, ang); r = __builtin_fma(-q, 6.123233995736766e-17, r);
        const double r2 = r * r;
        const double sn = r * (1.0 + r2 * (-1.0 / 6 + r2 * (1.0 / 120 + r2 * (-1.0 / 5040 + r2 * (1.0 / 362880 + r2 * (-1.0 / 39916800 + r2 * (1.0 / 6227020800.0)))))));
        const double cs = 1.0 + r2 * (-0.5 + r2 * (1.0 / 24 + r2 * (-1.0 / 720 + r2 * (1.0 / 40320 + r2 * (-1.0 / 3628800 + r2 * (1.0 / 479001600.0))))));
        const int qi = ((int)q) & 3;
        const double c = qi == 0 ? cs : qi == 1 ? -sn : qi == 2 ? -cs : sn;
        const double s = qi == 0 ? sn : qi == 1 ? cs : qi == 2 ? -sn : -cs;
        ((f32x2*)(ws + WS_ROPE))[i] = (f32x2){(float)c, (float)s};
    }
    for (int i = gt; i < DEPTH * NH * CH * CH; i += NGT) { const int jj = i & 127, ii = (i >> 7) & 127; ((bf16*)(ws + WS_WG))[i] = jj <= ii ? (bf16)f2bf(a.in[6][i]) : (bf16)0; }
}

__device__ __forceinline__ void sample_ret_item(const Args& a, int l, int item, int lane) {
    const int b = item >> 3, h = item & 7; const size_t row = (size_t)MP + b;
    const bf16* Qg = (const bf16*)(a.ws + WS_Q) + row * 1024 + 128 * h; const bf16* Kg = (const bf16*)(a.ws + WS_K) + row * 1024 + 128 * h;
    const bf16* Vg = (const bf16*)(a.ws + WS_V) + row * 1024 + 128 * h; const bf16* Gg = (const bf16*)(a.ws + WS_SGR) + row * 1024 + 128 * h;
    const int c4 = lane & 31, r2 = lane >> 5;
    const float* S0 = a.in[2] + ((((size_t)l * DECB + b) * NH + h) * HD) * HD + (size_t)r2 * HD + 4 * c4;
    float* S1 = a.out + OUT_SS + ((((size_t)l * DECB + b) * NH + h) * HD) * HD + (size_t)r2 * HD + 4 * c4;
    const float gam = exp2f(lg2gamma(h));
    const unsigned qw = *(const unsigned*)(Qg + 2 * lane), kw = *(const unsigned*)(Kg + 2 * lane);
    const v2u vw = *(const v2u*)(Vg + 4 * c4), gw = *(const v2u*)(Gg + 4 * c4);
    const float v0 = bflo(vw.x), v1 = bfhi(vw.x), v2 = bflo(vw.y), v3 = bfhi(vw.y);
    f32x4 o = {0.f, 0.f, 0.f, 0.f};
#pragma unroll
    for (int tb = 0; tb < 4; ++tb) {
        f32x4 sv[16];
#pragma unroll
        for (int u = 0; u < 16; ++u) sv[u] = *(const f32x4*)(S0 + (size_t)(2 * (16 * tb + u)) * HD);
#pragma unroll
        for (int u = 0; u < 16; ++u) { const int t = 16 * tb + u;
            const unsigned qq = __shfl(qw, t), kk = __shfl(kw, t);
            const float qd = r2 ? bfhi(qq) : bflo(qq), kd = r2 ? bfhi(kk) : bflo(kk);
            f32x4 t1; t1.x = sv[u].x + kd * v0; t1.y = sv[u].y + kd * v1; t1.z = sv[u].z + kd * v2; t1.w = sv[u].w + kd * v3;
            o += t1 * qd; *(f32x4*)(S1 + (size_t)(2 * t) * HD) = t1 * gam; }
    }
    o.x += __shfl_xor(o.x, 32); o.y += __shfl_xor(o.y, 32); o.z += __shfl_xor(o.z, 32); o.w += __shfl_xor(o.w, 32);
    float ss = (o.x * o.x + o.y * o.y) + (o.z * o.z + o.w * o.w);
#pragma unroll
    for (int s = 1; s < 32; s <<= 1) ss += __shfl_xor(ss, s);
    const float rs = rsqrtf(ss * (1.0f / 128.0f) + EPS);
    if (r2 == 0) { v2u w; w.x = pk2(o.x * rs * bflo(gw.x), o.y * rs * bfhi(gw.x)); w.y = pk2(o.z * rs * bflo(gw.y), o.w * rs * bfhi(gw.y));
        *(v2u*)((bf16*)(a.ws + WS_CAT) + row * 2048 + 128 * h + 4 * c4) = w; }
}
__device__ __forceinline__ void sample_gm_item(const Args& a, int l, int b, int lane) {
    const size_t row = (size_t)MP + b;
    const f32x4* lp = (const f32x4*)((const float*)(a.ws + WS_LNS) + row * 32); float s1 = 0.f, s2 = 0.f;
#pragma unroll
    for (int i = 0; i < 8; ++i) { const f32x4 p = lp[i]; s1 += p.x + p.z; s2 += p.y + p.w; }
    const float mu = s1 * (1.0f / 1024.0f), var = s2 * (1.0f / 1024.0f) - mu * mu, rstd = rsqrtf(var + EPS);
    const bf16* vg = (const bf16*)(a.ws + WS_VG) + row * 1024; const bf16* ug = (const bf16*)(a.ws + WS_UG) + row * 1024;
    float* gv = a.out + OUT_GV + ((size_t)l * DECB + b) * 1024; bf16* cat = (bf16*)(a.ws + WS_CAT) + row * 2048 + 1024;
    v2u vw[4], uw[4]; f32x4 lg[4], lb[4]; float w00[4], b0[4];
#pragma unroll
    for (int j = 0; j < 4; ++j) { const int c = 4 * lane + 256 * j, h = c >> 7;
        vw[j] = *(const v2u*)(vg + c); uw[j] = *(const v2u*)(ug + c); lg[j] = *(const f32x4*)(a.in[8] + l * 1024 + c); lb[j] = *(const f32x4*)(a.in[9] + l * 1024 + c);
        w00[j] = a.in[6][((size_t)l * NH + h) * CH * CH]; b0[j] = a.in[7][((size_t)l * NH + h) * CH]; }
#pragma unroll
    for (int j = 0; j < 4; ++j) { const int c = 4 * lane + 256 * j;
        f32x4 vn; vn.x = (bflo(vw[j].x) - mu) * rstd * lg[j].x + lb[j].x; vn.y = (bfhi(vw[j].x) - mu) * rstd * lg[j].y + lb[j].y;
        vn.z = (bflo(vw[j].y) - mu) * rstd * lg[j].z + lb[j].z; vn.w = (bfhi(vw[j].y) - mu) * rstd * lg[j].w + lb[j].w;
        *(f32x4*)(gv + c) = vn;
        v2u w; w.x = pk2((w00[j] * vn.x + b0[j]) * bflo(uw[j].x), (w00[j] * vn.y + b0[j]) * bfhi(uw[j].x)); w.y = pk2((w00[j] * vn.z + b0[j]) * bflo(uw[j].y), (w00[j] * vn.w + b0[j]) * bfhi(uw[j].y));
        *(v2u*)(cat + c) = w; }
}
typedef short s16x4 __attribute__((ext_vector_type(4)));
typedef short bf16x8 __attribute__((ext_vector_type(8)));
typedef float f32x16 __attribute__((ext_vector_type(16)));
typedef __bf16 bf16x2v __attribute__((ext_vector_type(2)));
#define MFMA32(a, b, c) __builtin_amdgcn_mfma_f32_32x32x16_bf16((a), (b), (c), 0, 0, 0)
__device__ __forceinline__ unsigned pkbf(float lo, float hi) { const bf16x2v r = __builtin_convertvector((f32x2){lo, hi}, bf16x2v); return __builtin_bit_cast(unsigned, r); }
__device__ __forceinline__ unsigned offb(unsigned row, unsigned ch) { return 256u * row + 16u * (ch ^ (((row & 3u) << 2) | ((row >> 2) & 3u))); }
__device__ __forceinline__ bf16x8 rowfrag(LAS unsigned char* tile, int R0, int lane, int s) { return *(const LAS bf16x8*)(tile + offb(R0 + (lane & 31), 2 * s + (lane >> 5))); }
template <bool PERMK> __device__ __forceinline__ bf16x8 trfrag(LAS unsigned char* tile, int R0, int lane, int c, int ks) {
    const int hh = lane >> 5, blk = (lane >> 4) & 1, q = (lane & 15) >> 2, p = lane & 3;
    const int r0 = R0 + 16 * ks + (PERMK ? 4 * hh : 8 * hh) + q, r1 = r0 + (PERMK ? 8 : 4), ch = 4 * c + 2 * blk + (p >> 1);
    const s16x4 lo = __builtin_amdgcn_ds_read_tr16_b64_v4i16((LAS s16x4*)(tile + offb(r0, ch) + 8 * (p & 1)));
    const s16x4 hi = __builtin_amdgcn_ds_read_tr16_b64_v4i16((LAS s16x4*)(tile + offb(r1, ch) + 8 * (p & 1)));
    return __builtin_shufflevector(lo, hi, 0, 1, 2, 3, 4, 5, 6, 7);
}
__device__ __forceinline__ bf16x8 trfrag64(LAS unsigned char* tile, int lane, int ks) {
    const int hh = lane >> 5, blk = (lane >> 4) & 1, q = (lane & 15) >> 2, p = lane & 3;
    const int r0 = 16 * ks + 8 * hh + q; const int cb = (2 * blk + (p >> 1)) * 16 + 8 * (p & 1);
    const s16x4 lo = __builtin_amdgcn_ds_read_tr16_b64_v4i16((LAS s16x4*)(tile + r0 * 64 + cb));
    const s16x4 hi = __builtin_amdgcn_ds_read_tr16_b64_v4i16((LAS s16x4*)(tile + (r0 + 4) * 64 + cb));
    return __builtin_shufflevector(lo, hi, 0, 1, 2, 3, 4, 5, 6, 7);
}
__device__ __forceinline__ bf16x8 packx(const f32x16& x, int s) {
    v4u p; p.x = pkbf(x[8 * s + 0], x[8 * s + 1]); p.y = pkbf(x[8 * s + 2], x[8 * s + 3]); p.z = pkbf(x[8 * s + 4], x[8 * s + 5]); p.w = pkbf(x[8 * s + 6], x[8 * s + 7]);
    return __builtin_bit_cast(bf16x8, p);
}
__device__ __forceinline__ void stage_tile(LAS unsigned char* tile, const bf16* src, int ld, int tid) {
    v4u w[4];
#pragma unroll
    for (int i = 0; i < 4; ++i) { const int ch = tid + i * NTHR; w[i] = *(const v4u*)(src + (size_t)(ch >> 4) * ld + (ch & 15) * 8); }
#pragma unroll
    for (int i = 0; i < 4; ++i) { const int ch = tid + i * NTHR; *(LAS v4u*)(tile + offb(ch >> 4, ch & 15)) = w[i]; }
}
constexpr int T32K = 32768;

__device__ __forceinline__ void kvscan_wave(const Args& a, int l, int item, int dkb, LAS unsigned char* wl, int lane) {
    const int b = item >> 5, hd = (item >> 2) & 7, dq = item & 3, hh = lane >> 5, cl = lane & 31;
    LAS unsigned char* Kb = wl; LAS unsigned char* Vb = wl + 8192;
    const bf16* Kg = (const bf16*)(a.ws + WS_K) + (size_t)b * SEQ * 1024 + 128 * hd + 32 * dkb + (lane & 3) * 8 + (size_t)(lane >> 2) * 1024;
    const bf16* Vg = (const bf16*)(a.ws + WS_V) + (size_t)b * SEQ * 1024 + 128 * hd + 32 * dq + (lane & 3) * 8 + (size_t)(lane >> 2) * 1024;
    bf16* ST = (bf16*)(a.ws + WS_ST) + ((((size_t)b * NCH) * NH + hd) * HD + 32 * dq + cl) * HD + 32 * dkb + 4 * hh;
    f32x16 S;
#pragma unroll
    for (int i = 0; i < 16; ++i) S[i] = 0.f;
    const float g128 = exp2f(lg2gamma(hd) * 128.0f);
    v4u kr[8], vr[8];
#pragma unroll
    for (int i = 0; i < 8; ++i) { kr[i] = *(const v4u*)(Kg + (size_t)i * 16 * 1024); vr[i] = *(const v4u*)(Vg + (size_t)i * 16 * 1024); }
    for (int c = 0; c < NCH; ++c) {
        { bf16* st = ST + (size_t)c * NH * HD * HD;
#pragma unroll
          for (int g = 0; g < 4; ++g) { v2u o; o.x = pkbf(S[4 * g], S[4 * g + 1]); o.y = pkbf(S[4 * g + 2], S[4 * g + 3]); *(v2u*)(st + 8 * g) = o; } }
#pragma unroll
        for (int i = 0; i < 8; ++i) { *(LAS v4u*)(Kb + (lane + 64 * i) * 16) = kr[i]; *(LAS v4u*)(Vb + (lane + 64 * i) * 16) = vr[i]; }
        if (c + 1 < NCH) { const size_t o = (size_t)(c + 1) * CH * 1024;
#pragma unroll
            for (int i = 0; i < 8; ++i) { kr[i] = *(const v4u*)(Kg + o + (size_t)i * 16 * 1024); vr[i] = *(const v4u*)(Vg + o + (size_t)i * 16 * 1024); } }
#pragma unroll
        for (int ks = 0; ks < 8; ++ks) { const bf16x8 A = trfrag64(Kb, lane, ks); const bf16x8 B = trfrag64(Vb, lane, ks); S = MFMA32(A, B, S); }
#pragma unroll
        for (int i = 0; i < 16; ++i) S[i] *= g128;
    }
    float* so = a.out + OUT_SP + ((((size_t)l * BATCH + b) * NH + hd) * HD) * HD + 32 * dq + cl;
#pragma unroll
    for (int i = 0; i < 16; ++i) so[(size_t)(32 * dkb + (i & 3) + 8 * (i >> 2) + 4 * hh) * HD] = S[i];
}
__device__ __forceinline__ void ret_item_mfma(const Args& a, int l, int item, LAS unsigned char* lds, int tid) {
    const int b = item >> 7, c = (item >> 3) & 15, hd = item & 7, lane = tid & 63, w = __builtin_amdgcn_readfirstlane(tid >> 6), hh = lane >> 5, cl = lane & 31, ib = w & 3, dh = w >> 2;
    const size_t row0 = (size_t)b * SEQ + c * CH;
    LAS unsigned char* Qt = lds; LAS unsigned char* Kt = lds + T32K; LAS unsigned char* Vt = lds + 2 * T32K; LAS unsigned char* St = lds + 3 * T32K; LAS float* red = (LAS float*)(lds + 4 * T32K);
    __syncthreads();
    stage_tile(Qt, (const bf16*)(a.ws + WS_Q) + row0 * 1024 + 128 * hd, 1024, tid);
    stage_tile(Kt, (const bf16*)(a.ws + WS_K) + row0 * 1024 + 128 * hd, 1024, tid);
    stage_tile(Vt, (const bf16*)(a.ws + WS_V) + row0 * 1024 + 128 * hd, 1024, tid);
    stage_tile(St, (const bf16*)(a.ws + WS_ST) + ((((size_t)b * NCH + c) * NH + hd) * HD) * HD, 128, tid);
    __syncthreads();
    const size_t row = row0 + 32 * ib + cl;
    const bf16* Gg = (const bf16*)(a.ws + WS_SGR) + row * 1024 + 128 * hd + 64 * dh + 4 * hh;
    v2u gp[8];
#pragma unroll
    for (int g = 0; g < 4; ++g) { gp[g] = *(const v2u*)(Gg + 8 * g); gp[4 + g] = *(const v2u*)(Gg + 32 + 8 * g); }
    bf16x8 qf[8];
#pragma unroll
    for (int s = 0; s < 8; ++s) qf[s] = rowfrag(Qt, 32 * ib, lane, s);
    f32x16 o0, o1;
#pragma unroll
    for (int i = 0; i < 16; ++i) { o0[i] = 0.f; o1[i] = 0.f; }
    for (int jb = 0; jb <= ib; ++jb) {
        f32x16 X;
#pragma unroll
        for (int i = 0; i < 16; ++i) X[i] = 0.f;
#pragma unroll
        for (int s = 0; s < 8; ++s) X = MFMA32(rowfrag(Kt, 32 * jb, lane, s), qf[s], X);
        if (jb == ib) {
#pragma unroll
            for (int i = 0; i < 16; ++i) { const int jl = (i & 3) + 8 * (i >> 2) + 4 * hh; X[i] = jl <= cl ? X[i] : 0.f; }
        }
#pragma unroll
        for (int s2 = 0; s2 < 2; ++s2) { const bf16x8 xb = packx(X, s2);
            o0 = MFMA32(trfrag<true>(Vt, 32 * jb, lane, 2 * dh + 0, s2), xb, o0);
            o1 = MFMA32(trfrag<true>(Vt, 32 * jb, lane, 2 * dh + 1, s2), xb, o1); }
    }
#pragma unroll
    for (int s = 0; s < 8; ++s) { o0 = MFMA32(rowfrag(St, 32 * (2 * dh + 0), lane, s), qf[s], o0); o1 = MFMA32(rowfrag(St, 32 * (2 * dh + 1), lane, s), qf[s], o1); }
    float ssq = 0.f;
#pragma unroll
    for (int i = 0; i < 16; ++i) ssq += o0[i] * o0[i] + o1[i] * o1[i];
    ssq += __shfl_xor(ssq, 32);
    if (lane < 32) red[w * 32 + lane] = ssq;
    __syncthreads();
    const float rs = rsqrtf((red[ib * 32 + cl] + red[(ib + 4) * 32 + cl]) * (1.0f / 128.0f) + EPS);
    bf16* cat = (bf16*)(a.ws + WS_CAT) + row * 2048 + 128 * hd + 64 * dh + 4 * hh;
#pragma unroll
    for (int g = 0; g < 4; ++g) {
        const v2u g0 = gp[g], g1 = gp[4 + g]; v2u w0, w1;
        w0.x = pkbf(o0[4 * g] * rs * bflo(g0.x), o0[4 * g + 1] * rs * bfhi(g0.x)); w0.y = pkbf(o0[4 * g + 2] * rs * bflo(g0.y), o0[4 * g + 3] * rs * bfhi(g0.y));
        w1.x = pkbf(o1[4 * g] * rs * bflo(g1.x), o1[4 * g + 1] * rs * bfhi(g1.x)); w1.y = pkbf(o1[4 * g + 2] * rs * bflo(g1.y), o1[4 * g + 3] * rs * bfhi(g1.y));
        *(v2u*)(cat + 8 * g) = w0; *(v2u*)(cat + 32 + 8 * g) = w1; }
}
__device__ __forceinline__ void gm_item_mfma(const Args& a, int l, int item, LAS unsigned char* lds, int tid) {
    const int b = item >> 7, c = (item >> 3) & 15, hd = item & 7, lane = tid & 63, w = __builtin_amdgcn_readfirstlane(tid >> 6), hh = lane >> 5, cl = lane & 31, ib = w & 3, gh = w >> 2;
    const size_t row0 = (size_t)b * SEQ + c * CH;
    LAS unsigned char* VNt = lds; LAS unsigned char* Wt = lds + T32K; LAS float* ST2 = (LAS float*)(lds + 2 * T32K);
    __syncthreads();
    if (tid < 128) { const float* lp = (const float*)(a.ws + WS_LNS) + (row0 + tid) * 32; float s1 = 0.f, s2 = 0.f;
#pragma unroll
        for (int i = 0; i < 16; ++i) { s1 += lp[2 * i]; s2 += lp[2 * i + 1]; }
        const float mu = s1 * (1.0f / 1024.0f), var = s2 * (1.0f / 1024.0f) - mu * mu; ST2[2 * tid] = mu; ST2[2 * tid + 1] = rsqrtf(var + EPS); }
    stage_tile(Wt, (const bf16*)(a.ws + WS_WG) + ((size_t)l * NH + hd) * CH * CH, 128, tid);
    __syncthreads();
    { const bf16* vg = (const bf16*)(a.ws + WS_VG) + row0 * 1024 + 128 * hd; const float* lg = a.in[8] + l * 1024 + 128 * hd; const float* lb = a.in[9] + l * 1024 + 128 * hd;
#pragma unroll
      for (int i = 0; i < 4; ++i) { const int ch = tid + i * NTHR, r = ch >> 4, c0 = (ch & 15) * 8; const v4u x = *(const v4u*)(vg + (size_t)r * 1024 + c0);
          const float mu = ST2[2 * r], rstd = ST2[2 * r + 1]; const f32x4 g0 = *(const f32x4*)(lg + c0), g1 = *(const f32x4*)(lg + c0 + 4), b0 = *(const f32x4*)(lb + c0), b1 = *(const f32x4*)(lb + c0 + 4);
          v4u o; o.x = pkbf((bflo(x.x) - mu) * rstd * g0.x + b0.x, (bfhi(x.x) - mu) * rstd * g0.y + b0.y); o.y = pkbf((bflo(x.y) - mu) * rstd * g0.z + b0.z, (bfhi(x.y) - mu) * rstd * g0.w + b0.w);
          o.z = pkbf((bflo(x.z) - mu) * rstd * g1.x + b1.x, (bfhi(x.z) - mu) * rstd * g1.y + b1.y); o.w = pkbf((bflo(x.w) - mu) * rstd * g1.z + b1.z, (bfhi(x.w) - mu) * rstd * g1.w + b1.w);
          *(LAS v4u*)(VNt + offb(r, ch & 15)) = o; } }
    __syncthreads();
    const float bi = a.in[7][((size_t)l * NH + hd) * CH + 32 * ib + cl];
    const size_t row = row0 + 32 * ib + cl;
    const bf16* Ug = (const bf16*)(a.ws + WS_UG) + row * 1024 + 128 * hd + 64 * gh + 4 * hh;
    v2u gp[8];
#pragma unroll
    for (int g = 0; g < 4; ++g) { gp[g] = *(const v2u*)(Ug + 8 * g); gp[4 + g] = *(const v2u*)(Ug + 32 + 8 * g); }
    f32x16 s0, s1;
#pragma unroll
    for (int i = 0; i < 16; ++i) { s0[i] = 0.f; s1[i] = 0.f; }
    for (int ks = 0; ks < 2 * (ib + 1); ++ks) { const bf16x8 B = rowfrag(Wt, 32 * ib, lane, ks);
        s0 = MFMA32(trfrag<false>(VNt, 0, lane, 2 * gh + 0, ks), B, s0); s1 = MFMA32(trfrag<false>(VNt, 0, lane, 2 * gh + 1, ks), B, s1); }
    bf16* cat = (bf16*)(a.ws + WS_CAT) + row * 2048 + 1024 + 128 * hd + 64 * gh + 4 * hh;
#pragma unroll
    for (int g = 0; g < 4; ++g) {
        const v2u g0 = gp[g], g1 = gp[4 + g]; v2u w0, w1;
        w0.x = pkbf((s0[4 * g] + bi) * bflo(g0.x), (s0[4 * g + 1] + bi) * bfhi(g0.x)); w0.y = pkbf((s0[4 * g + 2] + bi) * bflo(g0.y), (s0[4 * g + 3] + bi) * bfhi(g0.y));
        w1.x = pkbf((s1[4 * g] + bi) * bflo(g1.x), (s1[4 * g + 1] + bi) * bfhi(g1.x)); w1.y = pkbf((s1[4 * g + 2] + bi) * bflo(g1.y), (s1[4 * g + 3] + bi) * bfhi(g1.y));
        *(v2u*)(cat + 8 * g) = w0; *(v2u*)(cat + 32 + 8 * g) = w1; }
}

template <int NB, class Epi>
__device__ __forceinline__ void small_gemm_piece(const bf16* X, const bf16* W0, const bf16* W1, int K, LAS unsigned char* lds, int tid, const Epi& E) {
    const int lane = tid & 63, w = __builtin_amdgcn_readfirstlane(tid >> 6), hh = lane >> 5, cl = lane & 31, ib = w & 3, kh = w >> 2;
    const int nsl = K >> 7;
    const int xr_ = tid >> 4, xc_ = tid & 15;
    const bf16* xs = X + (size_t)xr_ * K + xc_ * 8; const bf16* ws0 = W0 + (size_t)xr_ * K + xc_ * 8; const bf16* ws1 = W1 + (size_t)xr_ * K + xc_ * 8;
    f32x16 acc[NB];
#pragma unroll
    for (int nb = 0; nb < NB; ++nb)
#pragma unroll
        for (int i = 0; i < 16; ++i) acc[nb][i] = 0.f;
    v4u xv[4], wv[NB];
#pragma unroll
    for (int i = 0; i < 4; ++i) xv[i] = *(const v4u*)(xs + (size_t)(32 * i) * K);
    wv[0] = *(const v4u*)ws0; if (NB > 1) wv[NB - 1] = *(const v4u*)ws1;
    __syncthreads();
    for (int sl = 0; sl < nsl; ++sl) {
        LAS unsigned char* Xt = lds + (sl & 1) * 49152; LAS unsigned char* Wt = Xt + 32768;
#pragma unroll
        for (int i = 0; i < 4; ++i) *(LAS v4u*)(Xt + offb(xr_ + 32 * i, xc_)) = xv[i];
        *(LAS v4u*)(Wt + offb(xr_, xc_)) = wv[0]; if (NB > 1) *(LAS v4u*)(Wt + offb(xr_ + 32, xc_)) = wv[NB - 1];
        __syncthreads();
        if (sl + 1 < nsl) { const int ko = (sl + 1) * 128;
#pragma unroll
            for (int i = 0; i < 4; ++i) xv[i] = *(const v4u*)(xs + (size_t)(32 * i) * K + ko);
            wv[0] = *(const v4u*)(ws0 + ko); if (NB > 1) wv[NB - 1] = *(const v4u*)(ws1 + ko); }
#pragma unroll
        for (int st = 0; st < 4; ++st) { const int ks = 4 * kh + st; const bf16x8 xf = rowfrag(Xt, 32 * ib, lane, ks);
            acc[0] = MFMA32(rowfrag(Wt, 0, lane, ks), xf, acc[0]);
            if (NB > 1) acc[NB - 1] = MFMA32(rowfrag(Wt, 32, lane, ks), xf, acc[NB - 1]); }
    }
    LAS float* red = (LAS float*)(lds + 98304);
    if (kh == 1) {
#pragma unroll
        for (int nb = 0; nb < NB; ++nb)
#pragma unroll
            for (int i = 0; i < 16; ++i) red[((ib * NB + nb) * 16 + i) * 64 + lane] = acc[nb][i];
    }
    __syncthreads();
    if (kh == 0) {
#pragma unroll
        for (int nb = 0; nb < NB; ++nb)
#pragma unroll
            for (int i = 0; i < 16; ++i) acc[nb][i] += red[((ib * NB + nb) * 16 + i) * 64 + lane];
        E(acc, ib, cl, hh);
    }
    __syncthreads();
}
struct EpiProjS {
    unsigned char* ws; const float* RR; int pn, sl;
    __device__ __forceinline__ void operator()(const f32x16 (&acc)[2], int ib, int cl, int hh) const {
        const int rs_ = 32 * ib + cl; const size_t row = (size_t)MP + rs_;
        const float rr = rsqrtf(RR[row] * (1.0f / 1024.0f) + EPS);
        if (pn < 8) {
            const int head = 2 * (pn & 3) + (sl >> 1), f0 = 32 * (sl & 1) + 4 * hh;
            const float e = lg2gamma(head);
            const float sc = rr * (pn < 4 ? exp2f(e) : exp2f(-e) * 0.08838834764831845f);
            const float* rope = (const float*)(ws + WS_ROPE) + ((size_t)SEQ * 64 + f0) * 2;
            bf16* dst = (bf16*)(ws + (pn < 4 ? WS_Q : WS_K)) + row * 1024 + 128 * head + f0;
#pragma unroll
            for (int g = 0; g < 4; ++g) { const f32x4 c0 = *(const f32x4*)(rope + 16 * g), c1 = *(const f32x4*)(rope + 16 * g + 4);
                const float a0 = acc[0][4 * g], a1 = acc[0][4 * g + 1], a2 = acc[0][4 * g + 2], a3 = acc[0][4 * g + 3];
                const float b0 = acc[1][4 * g], b1 = acc[1][4 * g + 1], b2 = acc[1][4 * g + 2], b3 = acc[1][4 * g + 3];
                v2u o1, o2;
                o1.x = pkbf((a0 * c0.x - b0 * c0.y) * sc, (a1 * c0.z - b1 * c0.w) * sc); o1.y = pkbf((a2 * c1.x - b2 * c1.y) * sc, (a3 * c1.z - b3 * c1.w) * sc);
                o2.x = pkbf((a0 * c0.y + b0 * c0.x) * sc, (a1 * c0.w + b1 * c0.z) * sc); o2.y = pkbf((a2 * c1.y + b2 * c1.x) * sc, (a3 * c1.w + b3 * c1.z) * sc);
                *(v2u*)(dst + 8 * g) = o1; *(v2u*)(dst + 64 + 8 * g) = o2; }
        } else if (pn < 16) {
            const bool isv = pn < 12;
            bf16* dst = (bf16*)(ws + (isv ? WS_V : WS_SGR)) + row * 1024 + 256 * (isv ? pn - 8 : pn - 12) + 32 * sl + 4 * hh;
#pragma unroll
            for (int nb = 0; nb < 2; ++nb)
#pragma unroll
                for (int g = 0; g < 4; ++g) { float v0 = acc[nb][4 * g] * rr, v1 = acc[nb][4 * g + 1] * rr, v2 = acc[nb][4 * g + 2] * rr, v3 = acc[nb][4 * g + 3] * rr;
                    if (!isv) { v0 = silu_f(v0); v1 = silu_f(v1); v2 = silu_f(v2); v3 = silu_f(v3); }
                    v2u o; o.x = pkbf(v0, v1); o.y = pkbf(v2, v3); *(v2u*)(dst + 128 * nb + 8 * g) = o; }
        } else if (pn < 24) {
            bf16* dst = (bf16*)(ws + WS_UG) + row * 1024 + 128 * (pn - 16) + 32 * sl + 4 * hh;
#pragma unroll
            for (int g = 0; g < 4; ++g) { v2u o;
                o.x = pkbf(acc[0][4 * g] * rr * silu_f(acc[1][4 * g] * rr), acc[0][4 * g + 1] * rr * silu_f(acc[1][4 * g + 1] * rr));
                o.y = pkbf(acc[0][4 * g + 2] * rr * silu_f(acc[1][4 * g + 2] * rr), acc[0][4 * g + 3] * rr * silu_f(acc[1][4 * g + 3] * rr));
                *(v2u*)(dst + 8 * g) = o; }
        } else {
            bf16* dst = (bf16*)(ws + WS_VG) + row * 1024 + 256 * (pn - 24) + 32 * sl + 4 * hh;
            float s1 = 0.f, s2 = 0.f;
#pragma unroll
            for (int nb = 0; nb < 2; ++nb)
#pragma unroll
                for (int g = 0; g < 4; ++g) { const float v0 = acc[nb][4 * g] * rr, v1 = acc[nb][4 * g + 1] * rr, v2 = acc[nb][4 * g + 2] * rr, v3 = acc[nb][4 * g + 3] * rr;
                    s1 += (v0 + v1) + (v2 + v3); s2 += (v0 * v0 + v1 * v1) + (v2 * v2 + v3 * v3);
                    v2u o; o.x = pkbf(v0, v1); o.y = pkbf(v2, v3); *(v2u*)(dst + 128 * nb + 8 * g) = o; }
            s1 += __shfl_xor(s1, 32); s2 += __shfl_xor(s2, 32);
            if (hh == 0) *(f32x2*)((float*)(ws + WS_LNS) + (row * 16 + (pn - 24) * 4 + sl) * 2) = (f32x2){s1, s2};
        }
    }
};
struct EpiResS {
    const float* res; float* out; unsigned char* ws; float* RRn; int nbk;
    __device__ __forceinline__ void operator()(const f32x16 (&acc)[1], int ib, int cl, int hh) const {
        const int rs_ = 32 * ib + cl; const size_t o = (size_t)rs_ * 1024 + 32 * nbk + 4 * hh;
        bf16* xb = (bf16*)(ws + WS_XB) + (size_t)MP * 1024 + o; float ssq = 0.f;
        f32x4 r[4];
#pragma unroll
        for (int g = 0; g < 4; ++g) r[g] = *(const f32x4*)(res + o + 8 * g);
#pragma unroll
        for (int g = 0; g < 4; ++g) { f32x4 hn; hn.x = r[g].x + acc[0][4 * g]; hn.y = r[g].y + acc[0][4 * g + 1]; hn.z = r[g].z + acc[0][4 * g + 2]; hn.w = r[g].w + acc[0][4 * g + 3];
            *(f32x4*)(out + o + 8 * g) = hn; ssq += (hn.x * hn.x + hn.y * hn.y) + (hn.z * hn.z + hn.w * hn.w);
            v2u wv; wv.x = pkbf(hn.x, hn.y); wv.y = pkbf(hn.z, hn.w); *(v2u*)(xb + 8 * g) = wv; }
        ssq += __shfl_xor(ssq, 32);
        if (hh == 0) atomicAdd(RRn + MP + rs_, ssq);
    }
};

constexpr int NPHASE = 10;
__global__ void __launch_bounds__(NTHR, 2) fwd_kernel(Args args) {
    extern __shared__ __attribute__((aligned(16))) unsigned char lds_raw[];
    LAS unsigned char* lds = (LAS unsigned char*)lds_raw;
    volatile LAS unsigned* MISC = (volatile LAS unsigned*)(lds + MISC_OFF);
    const int G = gridDim.x, bx = blockIdx.x, NGW = G * NWAVES;
    if (threadIdx.x < 128) MISC[threadIdx.x] = 0u;
#define PHASE_IDS() int tid = threadIdx.x; asm volatile("" : "+v"(tid)); const int lane = tid & 63, wave = __builtin_amdgcn_readfirstlane(tid >> 6), gw = bx * NWAVES + wave; (void)lane; (void)gw
    __syncthreads();
#if MK_PER_PHASE
#define GRID_BAR() do { } while (0)
#else
    XcdBarrier bar = xcd_barrier_post((unsigned*)(args.ws + WS_CTL) + 1024, MISC + 8);
#define GRID_BAR() xcd_barrier(bar)
#endif
    const int lo = args.ph_lo, hi = args.ph_hi;
#define IN(k) (lo <= (k) && (k) < hi)
#define SEAM(k) do { if (IN(k) && IN((k) + 1)) GRID_BAR(); } while (0)
#ifndef REPEAT_MASK
#define REPEAT_MASK 0
#endif
#define NREP(k) (((REPEAT_MASK >> (k)) & 1) ? 2 : 1)

    if (IN(0)) for (int rep = 0; rep < NREP(0); ++rep) { if (rep) GRID_BAR(); PHASE_IDS(); const Args a = fresh_args(); p0_prologue(a, lds, gw, NGW, lane, wave); }
    SEAM(0);
    for (int l = 0; l < DEPTH; ++l) {
        const int p = 1 + 4 * l;
        if (IN(p)) for (int rep = 0; rep < NREP(p); ++rep) {
            if (rep) GRID_BAR();
            const Args a = fresh_args();
            { PHASE_IDS();
              for (int pc = bx; pc < 28 * 4; pc += G) { const int pn = pc >> 2, sl = pc & 3;
                  const bf16* Wt = (const bf16*)(a.ws + WS_WT1) + (size_t)l * NIN * DM + (size_t)(256 * pn + 32 * sl) * DM;
                  EpiProjS ES{a.ws, (const float*)(a.ws + WS_RR) + (size_t)l * MPAD, pn, sl};
                  small_gemm_piece<2, EpiProjS>((const bf16*)(a.ws + WS_XB) + (size_t)MP * DM, Wt, Wt + (size_t)128 * DM, DM, lds, tid, ES); } }
            pg8::Gemm g{(const bf16*)(a.ws + WS_XB), (const bf16*)(a.ws + WS_WT1) + (size_t)l * NIN * DM, MP, NIN, DM};
            pg8::StaticOrder S; S.init(MP, NIN, G, bx);
            EpiProj E{a.ws, (const float*)(a.ws + WS_RR) + (size_t)l * MPAD};
            pg8::gemm_phase<EpiProj, pg8::StaticOrder, true, true>(lds + RING_OFF, g, S, E);
        }
        SEAM(p);
        if (IN(p + 1)) for (int rep = 0; rep < NREP(p + 1); ++rep) {
            if (rep) GRID_BAR();
            PHASE_IDS(); const Args a = fresh_args();
            if (wave < 4) { for (int it = bx; it < BATCH * NH * 4; it += G) kvscan_wave(a, l, it, wave, lds + wave * 16384, lane); }
            else { for (int it = bx * 4 + wave - 4; it < DECB * NH; it += 4 * G) sample_ret_item(a, l, it, lane);
                   for (int it = bx * 4 + wave - 4; it < DECB; it += 4 * G) sample_gm_item(a, l, it, lane); }
        }
        SEAM(p + 1);
        if (IN(p + 2)) for (int rep = 0; rep < NREP(p + 2); ++rep) {
            if (rep) GRID_BAR();
            PHASE_IDS(); const Args a = fresh_args();
            for (int it = bx; it < BATCH * NCH * NH; it += G) ret_item_mfma(a, l, it, lds, tid);
            for (int it = bx; it < BATCH * NCH * NH; it += G) gm_item_mfma(a, l, it, lds, tid);
            __syncthreads();
        }
        SEAM(p + 2);
        if (IN(p + 3)) for (int rep = 0; rep < NREP(p + 3); ++rep) {
            if (rep) GRID_BAR();
            const Args a = fresh_args();
            { PHASE_IDS();
              for (int pc = bx; pc < 32; pc += G) {
                  const bf16* Wt = (const bf16*)(a.ws + WS_WT2) + (size_t)l * DM * MIXW + (size_t)(32 * pc) * MIXW;
                  EpiResS ES{l == 0 ? a.in[1] : (const float*)(a.ws + WS_H32) + (size_t)MP * DM, l == 0 ? (float*)(a.ws + WS_H32) + (size_t)MP * DM : a.out + OUT_Y + (size_t)MP * DM, a.ws, (float*)(a.ws + WS_RR) + (size_t)(l + 1) * MPAD, pc};
                  small_gemm_piece<1, EpiResS>((const bf16*)(a.ws + WS_CAT) + (size_t)MP * MIXW, Wt, Wt, MIXW, lds, tid, ES); } }
            pg8::Gemm g{(const bf16*)(a.ws + WS_CAT), (const bf16*)(a.ws + WS_WT2) + (size_t)l * DM * MIXW, MP, DM, MIXW};
            pg8::StaticOrder S; S.init(MP, DM, G, bx);
            EpiRes E{l == 0 ? a.in[0] : (const float*)(a.ws + WS_H32), l == 0 ? (float*)(a.ws + WS_H32) : a.out + OUT_Y, a.ws, (float*)(a.ws + WS_RR) + (size_t)(l + 1) * MPAD};
            pg8::gemm_phase<EpiRes, pg8::StaticOrder, true, true>(lds + RING_OFF, g, S, E);
        }
        SEAM(p + 3);
    }
    if (IN(9)) {
        PHASE_IDS(); const Args a = fresh_args();
        const f32x4* fg = (const f32x4*)a.in[10] + lane; f32x4 fgv[4];
#pragma unroll
        for (int j = 0; j < 4; ++j) fgv[j] = fg[64 * j];
        const float* RR2 = (const float*)(a.ws + WS_RR) + (size_t)2 * MPAD;
        for (int m = 2 * gw; m < MT; m += 2 * NGW) {
            f32x4 v[2][4]; float ss[2];
#pragma unroll
            for (int r = 0; r < 2; ++r) { ss[r] = RR2[m + r]; const f32x4* yr = (const f32x4*)(a.out + OUT_Y + (size_t)(m + r) * DM) + lane;
#pragma unroll
                for (int j = 0; j < 4; ++j) v[r][j] = yr[64 * j]; }
#pragma unroll
            for (int r = 0; r < 2; ++r) { const float rr = rsqrtf(ss[r] * (1.0f / 1024.0f) + EPS); f32x4* yr = (f32x4*)(a.out + OUT_Y + (size_t)(m + r) * DM) + lane;
#pragma unroll
                for (int j = 0; j < 4; ++j) yr[64 * j] = v[r][j] * rr * fgv[j]; }
        }
    }
#undef IN
#undef SEAM
}

extern "C" void kernel_launch(void* const* d_in, const int* in_sizes, int n_in, void* d_out, int out_size, void* d_ws, size_t ws_size, hipStream_t stream) {
    static int grid = 0;
    if (grid == 0) {
        int dev = 0, cus = 0;
        if (n_in != 11 || ws_size < WS_END) { fprintf(stderr, "kernel_launch: unexpected n_in %d / ws_size %zu\n", n_in, ws_size); grid = -1; return; }
        if (hipGetDevice(&dev) != hipSuccess || hipDeviceGetAttribute(&cus, hipDeviceAttributeMultiprocessorCount, dev) != hipSuccess) { grid = -1; return; }
        if (hipFuncSetAttribute((const void*)fwd_kernel, hipFuncAttributeMaxDynamicSharedMemorySize, LDS_BYTES) != hipSuccess) { grid = -1; return; }
        (void)hipGetLastError();
        grid = cus;
    }
    if (grid < 0) return;
    (void)hipMemsetAsync((char*)d_ws + WS_CTL, 0, CTL_ZERO_BYTES, stream);
    Args a{};
    for (int i = 0; i < 11; ++i) a.in[i] = (const float*)d_in[i];
    a.out = (float*)d_out; a.ws = (unsigned char*)d_ws;
#if MK_PER_PHASE
    for (int p = 0; p < NPHASE; ++p) { a.ph_lo = p; a.ph_hi = p + 1; hipLaunchKernelGGL(fwd_kernel, dim3(grid), dim3(NTHR), LDS_BYTES, stream, a); }
#else
    a.ph_lo = 0; a.ph_hi = NPHASE; hipLaunchKernelGGL(fwd_kernel, dim3(grid), dim3(NTHR), LDS_BYTES, stream, a);
#endif
}
```

```cpp
#include <hip/hip_runtime.h>
#include <cstdio>
#include <cstdint>

#ifndef MK_PER_PHASE
#define MK_PER_PHASE 0
#endif

namespace pg8 {
#define PG8_LAS __attribute__((address_space(3)))
typedef unsigned short bf16_t;
typedef short bf16x8 __attribute__((ext_vector_type(8)));
typedef float f32x4 __attribute__((ext_vector_type(4)));
typedef unsigned u32x4 __attribute__((ext_vector_type(4)));
typedef unsigned u32x2 __attribute__((ext_vector_type(2)));
constexpr int BM = 256, BK = 64, HALF = 128, HTB = HALF * BK * 2  , STAGE_BYTES = 8 * HTB, NXCD = 8, WGM = 8;

__host__ __device__ __forceinline__ int lds_byte(int r, int c) { const int st = (r >> 4) * 2 + (c >> 5), rr = r & 15, cc = c & 31, ob = rr * 64 + cc * 2; return st * 1024 + (ob ^ (((ob >> 9) & 1) << 5)); }
__host__ __device__ __forceinline__ void stage_rc(int b, int& R, int& C) { const int st = b / 1024, sb = b % 1024, swz = sb ^ (((sb >> 9) & 1) << 5); R = (st >> 1) * 16 + swz / 64; C = (st & 1) * 32 + (swz % 64) / 2; }
__host__ __device__ __forceinline__ int perm32(int rho) { const int n = rho >> 4, i = rho & 15; return 8 * (i >> 2) + 4 * n + (i & 3); }

struct Unit { int pm, pn; };
struct Gemm { const bf16_t* A; const bf16_t* Bt; int M, N, K; };

struct StaticOrder {
    int nM, nN, nwg, G, c;
    __host__ __device__ void init(int M, int N, int G_, int c_) { nM = M / BM; nN = N / BM; nwg = nM * nN; G = G_; c = c_; }
    __host__ __device__ bool next(int i, Unit& u) const {
        const long L = (long)i * G + c; if (L >= nwg) return false;
        int wgid = (int)L; { const int q = nwg / NXCD, r = nwg % NXCD, xcd = wgid % NXCD, off = wgid / NXCD; wgid = (xcd < r ? xcd * (q + 1) : r * (q + 1) + (xcd - r) * q) + off; }
        const int nig = WGM * nN, gid = wgid / nig, fm = gid * WGM, gsz = (nM - fm) < WGM ? (nM - fm) : WGM;
        u.pm = fm + ((wgid % nig) % gsz); u.pn = (wgid % nig) / gsz; return true;
    }
    __device__ __forceinline__ void a_ready(const Unit&) const {}
    __device__ __forceinline__ void done(const Unit&) const {}
};

__device__ __forceinline__ unsigned cvt_pk_bf16(float lo, float hi) { unsigned r; asm volatile("v_cvt_pk_bf16_f32 %0, %1, %2" : "=v"(r) : "v"(lo), "v"(hi)); return r; }

template <class Epi, class Sched, bool ALIGN_EPI = false, bool SP2 = false>
__device__ __forceinline__ void gemm_phase(PG8_LAS unsigned char* lds, const Gemm g, const Sched& S, const Epi& E) {
    int tid_ = threadIdx.x; asm volatile("" : "+v"(tid_));
    const int tid = tid_, wid = __builtin_amdgcn_readfirstlane(tid >> 6), lane = tid & 63, wr = wid >> 2, wc = wid & 3, fr = lane & 15, fq = lane >> 4;
    const int K = g.K, nt = K / BK;
    unsigned voffA[2], voffB[2];
#pragma unroll
    for (int i = 0; i < 2; ++i) { int R, C; stage_rc(tid * 16 + i * 8192, R, C); const int Rb = Epi::PERM ? ((R & ~31) + perm32(R & 31)) : R;
        voffA[i] = (unsigned)(R * K + C) * 2u; voffB[i] = (unsigned)(Rb * K + C) * 2u; }
    const size_t kstep = (size_t)(BK * 2);
    const size_t hstep = (size_t)HALF * K * 2;
    const size_t tstep = 2 * hstep;
    const unsigned ldsw = (unsigned)wid * 1024u;
    const int aoff = lds_byte(wr * 64 + fr, fq * 8), boff = lds_byte(wc * 32 + fr, fq * 8);
#define PG8_SA(b, h) (((b) * 2 + (h)) * HTB)
#define PG8_SB(b, h) ((4 + (b) * 2 + (h)) * HTB)
#define PG8_STAGE(bufoff, gbase, voff) do { _Pragma("unroll") for (int _i = 0; _i < 2; ++_i) \
        __builtin_amdgcn_global_load_lds((const unsigned*)((const char*)(gbase) + (voff)[_i]), (PG8_LAS unsigned*)(lds + (bufoff) + ldsw + _i * 8192), 16, 0, 0); } while (0)
#define PG8_LDA(dst, b, h) do { _Pragma("unroll") for (int m = 0; m < 4; ++m) _Pragma("unroll") for (int k = 0; k < 2; ++k) dst[m][k] = *(const PG8_LAS bf16x8*)(lds + PG8_SA(b, h) + aoff + m * 2048 + k * 1024); } while (0)
#define PG8_LDB(dst, b, h) do { _Pragma("unroll") for (int n = 0; n < 2; ++n) _Pragma("unroll") for (int k = 0; k < 2; ++k) dst[n][k] = *(const PG8_LAS bf16x8*)(lds + PG8_SB(b, h) + boff + n * 2048 + k * 1024); } while (0)
#define PG8_MMA(ai, bj, At, Bt) do { __builtin_amdgcn_s_setprio(1); _Pragma("unroll") for (int m = 0; m < 4; ++m) _Pragma("unroll") for (int n = 0; n < 2; ++n) _Pragma("unroll") for (int k = 0; k < 2; ++k) \
        acc[ai][bj][m][n] = __builtin_amdgcn_mfma_f32_16x16x32_bf16(Bt[n][k], At[m][k], acc[ai][bj][m][n], 0, 0, 0); __builtin_amdgcn_s_setprio(0); } while (0)
#define PG8_WAIT_V(n) asm volatile("s_waitcnt vmcnt(" #n ")" ::: "memory")
#define PG8_WAIT_L(n) asm volatile("s_waitcnt lgkmcnt(" #n ")" ::: "memory")
#define PG8_BAR __builtin_amdgcn_s_barrier()
#define PG8_SCHED __builtin_amdgcn_sched_barrier(0)
    Unit cur, nxt; int ui = 0;
    if (!S.next(0, cur)) return;
    f32x4 acc[2][2][4][2];
#pragma unroll
    for (int a = 0; a < 2; ++a)
#pragma unroll
        for (int b = 0; b < 2; ++b)
#pragma unroll
            for (int m = 0; m < 4; ++m)
#pragma unroll
                for (int n = 0; n < 2; ++n) acc[a][b][m][n] = (f32x4){0.f, 0.f, 0.f, 0.f};
    bf16x8 At[4][2], B0[2][2], B1[2][2];
    const char* cA = (const char*)g.A + (size_t)cur.pm * tstep; const char* cB = (const char*)g.Bt + (size_t)cur.pn * tstep;
    S.a_ready(cur);
    if constexpr (SP2) {
        PG8_STAGE(PG8_SB(0, 0), cB, voffB); PG8_STAGE(PG8_SB(0, 1), cB + hstep, voffB); PG8_STAGE(PG8_SA(0, 0), cA, voffA); PG8_STAGE(PG8_SA(0, 1), cA + hstep, voffA);
        if (wr == 1) PG8_BAR;
        PG8_WAIT_V(2); PG8_BAR;
        PG8_STAGE(PG8_SB(1, 0), cB + kstep, voffB); PG8_STAGE(PG8_SA(1, 0), cA + kstep, voffA); PG8_STAGE(PG8_SB(1, 1), cB + hstep + kstep, voffB);
        PG8_WAIT_V(6); PG8_BAR;
    } else {
        PG8_STAGE(PG8_SB(0, 0), cB, voffB); PG8_STAGE(PG8_SA(0, 0), cA, voffA); PG8_STAGE(PG8_SB(0, 1), cB + hstep, voffB); PG8_STAGE(PG8_SA(0, 1), cA + hstep, voffA);
        if (wr == 1) PG8_BAR;
        PG8_WAIT_V(4); PG8_BAR;
        PG8_STAGE(PG8_SB(1, 0), cB + kstep, voffB); PG8_STAGE(PG8_SA(1, 0), cA + kstep, voffA); PG8_STAGE(PG8_SB(1, 1), cB + hstep + kstep, voffB);
        PG8_WAIT_V(6); PG8_BAR;
    }
    for (;;) {
        const bool has_next = S.next(ui + 1, nxt);
        const char* nA = has_next ? (const char*)g.A + (size_t)nxt.pm * tstep : cA; const char* nB = has_next ? (const char*)g.Bt + (size_t)nxt.pn * tstep : cB;
        for (int t = 0; t < nt; t += 2) {
            const bool last = (t == nt - 2);
            const char* a1 = cA + (size_t)(t + 1) * kstep;
            const char* a2 = last ? nA : cA + (size_t)(t + 2) * kstep; const char* b2 = last ? nB : cB + (size_t)(t + 2) * kstep;
            const char* a3 = a2 + kstep; const char* b3 = b2 + kstep;
            if (last && has_next) S.a_ready(nxt);
            if constexpr (SP2) {
            PG8_LDB(B0, 0, 0); PG8_LDB(B1, 0, 1); PG8_SCHED; PG8_LDA(At, 0, 0); PG8_STAGE(PG8_SA(1, 1), a1 + hstep, voffA);
            PG8_WAIT_V(8); PG8_WAIT_L(0); PG8_BAR; PG8_MMA(0, 0, At, B0); PG8_MMA(0, 1, At, B1); PG8_BAR; PG8_SCHED;
            PG8_LDA(At, 0, 1); PG8_STAGE(PG8_SB(0, 0), b2, voffB); PG8_STAGE(PG8_SB(0, 1), b2 + hstep, voffB); PG8_STAGE(PG8_SA(0, 0), a2, voffA);
            PG8_WAIT_V(8); PG8_WAIT_L(0); PG8_BAR; PG8_MMA(1, 0, At, B0); PG8_MMA(1, 1, At, B1); PG8_BAR; PG8_SCHED;
            PG8_LDB(B0, 1, 0); PG8_LDB(B1, 1, 1); PG8_SCHED; PG8_LDA(At, 1, 0); PG8_STAGE(PG8_SA(0, 1), a2 + hstep, voffA);
            PG8_WAIT_V(8); PG8_WAIT_L(0); PG8_BAR; PG8_MMA(0, 0, At, B0); PG8_MMA(0, 1, At, B1); PG8_BAR; PG8_SCHED;
            PG8_LDA(At, 1, 1); PG8_STAGE(PG8_SB(1, 0), b3, voffB); PG8_STAGE(PG8_SB(1, 1), b3 + hstep, voffB); PG8_STAGE(PG8_SA(1, 0), a3, voffA);
            PG8_WAIT_V(8); PG8_WAIT_L(0); PG8_BAR; PG8_MMA(1, 0, At, B0); PG8_MMA(1, 1, At, B1); PG8_BAR; PG8_SCHED;
            } else {
            PG8_LDB(B0, 0, 0); PG8_SCHED; PG8_LDA(At, 0, 0); PG8_STAGE(PG8_SA(1, 1), a1 + hstep, voffA);
            PG8_WAIT_L(8); PG8_BAR; PG8_WAIT_L(0); PG8_MMA(0, 0, At, B0); PG8_BAR; PG8_SCHED;
            PG8_LDB(B1, 0, 1); PG8_STAGE(PG8_SB(0, 0), b2, voffB);
            PG8_BAR; PG8_WAIT_L(0); PG8_MMA(0, 1, At, B1); PG8_BAR;
            PG8_LDA(At, 0, 1); PG8_STAGE(PG8_SA(0, 0), a2, voffA);
            PG8_BAR; PG8_WAIT_L(0); PG8_MMA(1, 0, At, B0); PG8_BAR; PG8_SCHED;
            PG8_STAGE(PG8_SB(0, 1), b2 + hstep, voffB);
            PG8_WAIT_V(6); PG8_BAR; PG8_MMA(1, 1, At, B1); PG8_BAR;
            PG8_LDB(B0, 1, 0); PG8_SCHED; PG8_LDA(At, 1, 0); PG8_STAGE(PG8_SA(0, 1), a2 + hstep, voffA);
            PG8_WAIT_L(8); PG8_BAR; PG8_WAIT_L(0); PG8_MMA(0, 0, At, B0); PG8_BAR; PG8_SCHED;
            PG8_LDB(B1, 1, 1); PG8_STAGE(PG8_SB(1, 0), b3, voffB);
            PG8_BAR; PG8_WAIT_L(0); PG8_MMA(0, 1, At, B1); PG8_BAR;
            PG8_LDA(At, 1, 1); PG8_STAGE(PG8_SA(1, 0), a3, voffA);
            PG8_BAR; PG8_WAIT_L(0); PG8_MMA(1, 0, At, B0); PG8_BAR; PG8_SCHED;
            PG8_STAGE(PG8_SB(1, 1), b3 + hstep, voffB);
            PG8_WAIT_V(6); PG8_BAR; PG8_MMA(1, 1, At, B1); PG8_BAR;
            }
        }
        if constexpr (ALIGN_EPI) { if (wr == 0) PG8_BAR; }
        E(acc, cur, wr, wc, fr, fq); S.done(cur);
        if (!has_next) break;
#pragma unroll
        for (int a = 0; a < 2; ++a)
#pragma unroll
            for (int b = 0; b < 2; ++b)
#pragma unroll
                for (int m = 0; m < 4; ++m)
#pragma unroll
                    for (int n = 0; n < 2; ++n) acc[a][b][m][n] = (f32x4){0.f, 0.f, 0.f, 0.f};
        cur = nxt; cA = nA; cB = nB; ++ui;
        if constexpr (ALIGN_EPI) { if (wr == 1) PG8_BAR; }
    }
    PG8_WAIT_V(0);
    if constexpr (!ALIGN_EPI) { if (wr == 0) PG8_BAR; }
    PG8_BAR;
#undef PG8_SA
#undef PG8_SB
#undef PG8_STAGE
#undef PG8_LDA
#undef PG8_LDB
#undef PG8_MMA
#undef PG8_WAIT_V
#undef PG8_WAIT_L
#undef PG8_BAR
#undef PG8_SCHED
}
}

constexpr int NWAVES = 8, NTHR = NWAVES * 64;
constexpr int DM = 1024, BATCH = 8, SEQ = 2048, DEPTH = 2, DECB = 128, PAST = 16384;
constexpr int MP = BATCH * SEQ;
constexpr int MT = MP + DECB;
constexpr int MPAD = 16640;
constexpr int NIN = 7168, MIXW = 2048, CH = 128, NH = 8, HD = 128, NCH = SEQ / CH;
constexpr float EPS = 1e-6f;

constexpr size_t MiB = 1u << 20;
constexpr size_t WS_CTL = 0, CTL_ZERO_BYTES = 64 * 1024;
constexpr size_t WS_WT1 = 1 * MiB;
constexpr size_t WS_WT2 = 29 * MiB;
constexpr size_t WS_WG  = 37 * MiB;
constexpr size_t WS_ROPE = 37 * MiB + 512 * 1024;
constexpr size_t WS_MUR = 39 * MiB;
constexpr size_t WS_RR = 40 * MiB;
constexpr size_t WS_LNS = 41 * MiB;
constexpr size_t WS_XB  = 44 * MiB;
constexpr size_t WS_H32 = 77 * MiB;
constexpr size_t PROJ_BYTES = (size_t)MPAD * 1024 * 2;
constexpr size_t WS_Q   = 142 * MiB;
constexpr size_t WS_K   = WS_Q + PROJ_BYTES;
constexpr size_t WS_V   = WS_K + PROJ_BYTES;
constexpr size_t WS_SGR = WS_V + PROJ_BYTES;
constexpr size_t WS_UG  = WS_SGR + PROJ_BYTES;
constexpr size_t WS_VG  = WS_UG + PROJ_BYTES;
constexpr size_t WS_CAT = 337 * MiB;
constexpr size_t WS_ST  = 402 * MiB;
constexpr size_t WS_END = 434 * MiB;
static_assert(WS_VG + PROJ_BYTES <= WS_CAT && WS_H32 + (size_t)MT * 1024 * 4 <= WS_Q && WS_XB + PROJ_BYTES <= WS_H32, "ws map");

constexpr size_t OUT_Y   = 0;
constexpr size_t OUT_SP  = (size_t)MT * 1024;
constexpr size_t OUT_SS  = OUT_SP + (size_t)DEPTH * BATCH * NH * HD * HD;
constexpr size_t OUT_GV  = OUT_SS + (size_t)DEPTH * DECB * NH * HD * HD;

constexpr int RING_OFF = 0, RING_BYTES = 131072;
constexpr int LDS_BYTES = 147456;
constexpr int MISC_OFF = LDS_BYTES - 512;

#define GAS __attribute__((address_space(1)))
#define LAS __attribute__((address_space(3)))
typedef unsigned short bf16;
typedef unsigned v4u __attribute__((ext_vector_type(4)));
typedef unsigned v2u __attribute__((ext_vector_type(2)));
typedef float f32x4 __attribute__((ext_vector_type(4)));
typedef float f32x2 __attribute__((ext_vector_type(2)));
#define LDS_WAIT() asm volatile("s_waitcnt lgkmcnt(0)" ::: "memory")
__device__ __forceinline__ unsigned f2bf(float f) { unsigned u = __builtin_bit_cast(unsigned, f); return (u + 0x7fffu + ((u >> 16) & 1u)) >> 16; }
__device__ __forceinline__ unsigned pk2(float lo, float hi) { return f2bf(lo) | (f2bf(hi) << 16); }
__device__ __forceinline__ float bf2f(unsigned b) { return __builtin_bit_cast(float, b << 16); }
__device__ __forceinline__ float bflo(unsigned w) { return __builtin_bit_cast(float, w << 16); }
__device__ __forceinline__ float bfhi(unsigned w) { return __builtin_bit_cast(float, w & 0xffff0000u); }
__device__ __forceinline__ float silu_f(float x) { return x * __builtin_amdgcn_rcpf(1.0f + __builtin_amdgcn_exp2f(-1.4426950408889634f * x)); }
__device__ __forceinline__ float wave_sum(float v) {
#pragma unroll
    for (int o = 1; o < 64; o <<= 1) v += __shfl_xor(v, o);
    return v;
}
__device__ __forceinline__ float lg2gamma(int h) {
    return h == 0 ? -0.04580368961312479f : h == 1 ? -0.02272007650008353f : h == 2 ? -0.011315313227834146f : h == 3 ? -0.005646563141142063f :
           h == 4 ? -0.0028205190623786626f : h == 5 ? -0.0014095702546713536f : h == 6 ? -0.0007046129765893727f : -0.0003522634716290214f;
}

#define XB_TMO      128
#define XB_XCNT(j)  (256  + 64 * (j))
#define XB_XSUB(j)  (1280 + 64 * (j))
#define XB_XGEN(j)  (2304 + 64 * (j))
#define XB_TOP      3328
#define XB_TOPGEN   3392
#define XCD_BAR_WORDS 3456
#define XB_SPIN_CAP (1u << 18)
__device__ __forceinline__ unsigned xb_ld(unsigned* p)              { return __hip_atomic_load(p, __ATOMIC_RELAXED, __HIP_MEMORY_SCOPE_AGENT); }
__device__ __forceinline__ unsigned xb_add(unsigned* p, unsigned v) { return __hip_atomic_fetch_add(p, v, __ATOMIC_RELAXED, __HIP_MEMORY_SCOPE_AGENT); }
__device__ __forceinline__ unsigned xb_xcc_id() { return (unsigned)__builtin_amdgcn_s_getreg((3 << 11) | 20) & 0xFu; }
#define XB_SPIN(cond, bar) do { unsigned _sp = 0; while (cond) { __builtin_amdgcn_s_sleep(1); \
    if ((++_sp & 255u) == 0u) { if (xb_ld(&(bar)[XB_TMO])) break; if (_sp > XB_SPIN_CAP) { atomicAdd(&(bar)[XB_TMO], 1u); break; } } } } while (0)
struct XcdBarrier { unsigned* bar; unsigned x; volatile LAS unsigned* st; };
__device__ __forceinline__ XcdBarrier xcd_barrier_post(unsigned* bar, volatile LAS unsigned* st) {
    XcdBarrier b; b.bar = bar; b.x = xb_xcc_id(); b.st = st;
    if (threadIdx.x == 0) (void)xb_add(&bar[XB_XCNT(b.x)], 1u);
    return b;
}
__device__ __forceinline__ void xcd_barrier_complete(unsigned* bar, unsigned x, unsigned& nloc, unsigned& nx) {
    const unsigned G = gridDim.x * gridDim.y * gridDim.z;
    unsigned sum, cnt, mine, sp = 0u;
    for (;;) {
        sum = 0u; cnt = 0u; mine = 0u;
#pragma unroll
        for (unsigned j = 0; j < 16; ++j) { const unsigned c = xb_ld(&bar[XB_XCNT(j)]); sum += c; cnt += (c > 0u) ? 1u : 0u; mine = (j == x) ? c : mine; }
        if (sum == G) break;
        __builtin_amdgcn_s_sleep(1);
        if ((++sp & 255u) == 0u) { if (xb_ld(&bar[XB_TMO])) break; if (sp > XB_SPIN_CAP) { atomicAdd(&bar[XB_TMO], 1u); break; } }
    }
    nloc = mine > 0u ? mine : 1u; nx = cnt > 0u ? cnt : 1u;
}
__device__ __forceinline__ void xcd_barrier(const XcdBarrier& b) {
    asm volatile("s_waitcnt vmcnt(0)" ::: "memory");
    __syncthreads();
    if (threadIdx.x == 0) {
        unsigned* bar = b.bar;
        __builtin_amdgcn_s_waitcnt(0);
        unsigned nloc = b.st[0], nx = b.st[1];
        if (nloc == 0u) { xcd_barrier_complete(bar, b.x, nloc, nx); b.st[0] = nloc; b.st[1] = nx; }
        const unsigned old = xb_add(&bar[XB_XSUB(b.x)], 1u);
        const unsigned gen = old / nloc;
        if (old + 1u == (gen + 1u) * nloc) {
            __builtin_amdgcn_fence(__ATOMIC_RELEASE, "agent");
            asm volatile("s_waitcnt vmcnt(0)" ::: "memory");
            const unsigned og = xb_add(&bar[XB_TOP], 1u);
            const unsigned tg = og / nx;
            if (og + 1u == (tg + 1u) * nx) xb_add(&bar[XB_TOPGEN], 1u);
            else XB_SPIN(xb_ld(&bar[XB_TOPGEN]) == tg, bar);
            __builtin_amdgcn_fence(__ATOMIC_ACQUIRE, "agent");
            xb_add(&bar[XB_XGEN(b.x)], 1u);
            asm volatile("s_waitcnt vmcnt(0)" ::: "memory");
        } else {
            XB_SPIN(xb_ld(&bar[XB_XGEN(b.x)]) == gen, bar);
            __builtin_amdgcn_fence(__ATOMIC_ACQUIRE, "agent");
            asm volatile("s_waitcnt vmcnt(0)" ::: "memory");
        }
    }
    __syncthreads();
}

struct EpiProj {
    static constexpr bool PERM = true;
    unsigned char* ws; const float* RR;
    __device__ __forceinline__ void operator()(const pg8::f32x4 (&acc)[2][2][4][2], const pg8::Unit& u, int wr, int wc, int fr, int fq) const {
        bf16* const Q = (bf16*)(ws + WS_Q); bf16* const K = (bf16*)(ws + WS_K); bf16* const V = (bf16*)(ws + WS_V); bf16* const SGR = (bf16*)(ws + WS_SGR);
        bf16* const UG = (bf16*)(ws + WS_UG); bf16* const VG = (bf16*)(ws + WS_VG); float* const LNS = (float*)(ws + WS_LNS);
        const float* const rope = (const float*)(ws + WS_ROPE);
        const int pn = u.pn, rowb = u.pm * 256 + wr * 64 + fr;
        float rrv[8];
#pragma unroll
        for (int it = 0; it < 8; ++it) rrv[it] = RR[rowb + (it >> 2) * 128 + (it & 3) * 16];
        if (pn < 8) {
            const int head = 2 * (pn & 3) + (wc >> 1), f0 = 32 * (wc & 1) + 8 * fq;
            const float lg = lg2gamma(head); bf16* const dstb = (pn < 4 ? Q : K) + 128 * head + f0;
            f32x4 cc[4], cn[4];
            { const f32x4* cs = (const f32x4*)(rope + ((size_t)(rowb & (SEQ - 1)) * 64 + f0) * 2);
#pragma unroll
              for (int t = 0; t < 4; ++t) cc[t] = cs[t]; }
#pragma unroll
            for (int it = 0; it < 8; ++it) {
                const int ai = it >> 2, m = it & 3, row = rowb + ai * 128 + m * 16;
                if (it < 7) { const int rown = rowb + ((it + 1) >> 2) * 128 + ((it + 1) & 3) * 16; const f32x4* cs = (const f32x4*)(rope + ((size_t)(rown & (SEQ - 1)) * 64 + f0) * 2);
#pragma unroll
                    for (int t = 0; t < 4; ++t) cn[t] = cs[t]; }
                const float rr = __builtin_amdgcn_rsqf(rrv[it] * (1.0f / 1024.0f) + EPS);
                const float e = lg * (float)((row & (CH - 1)) + 1);
                const float sc = rr * (pn < 4 ? __builtin_amdgcn_exp2f(e) : __builtin_amdgcn_exp2f(-e) * 0.08838834764831845f);
                float o1[8], o2[8];
#pragma unroll
                for (int t = 0; t < 4; ++t) { const f32x4 c4 = cc[t];
                    const int e0 = 2 * t, e1 = 2 * t + 1;
                    const float a0 = acc[ai][0][m][e0 >> 2][e0 & 3], b0 = acc[ai][1][m][e0 >> 2][e0 & 3];
                    const float a1 = acc[ai][0][m][e1 >> 2][e1 & 3], b1 = acc[ai][1][m][e1 >> 2][e1 & 3];
                    o1[e0] = (a0 * c4.x - b0 * c4.y) * sc; o2[e0] = (a0 * c4.y + b0 * c4.x) * sc;
                    o1[e1] = (a1 * c4.z - b1 * c4.w) * sc; o2[e1] = (a1 * c4.w + b1 * c4.z) * sc; }
                bf16* dst = dstb + (size_t)row * 1024;
                pg8::u32x4 w1, w2;
                w1.x = pg8::cvt_pk_bf16(o1[0], o1[1]); w1.y = pg8::cvt_pk_bf16(o1[2], o1[3]); w1.z = pg8::cvt_pk_bf16(o1[4], o1[5]); w1.w = pg8::cvt_pk_bf16(o1[6], o1[7]);
                w2.x = pg8::cvt_pk_bf16(o2[0], o2[1]); w2.y = pg8::cvt_pk_bf16(o2[2], o2[3]); w2.z = pg8::cvt_pk_bf16(o2[4], o2[5]); w2.w = pg8::cvt_pk_bf16(o2[6], o2[7]);
                *(pg8::u32x4*)dst = w1; *(pg8::u32x4*)(dst + 64) = w2;
#pragma unroll
                for (int t = 0; t < 4; ++t) cc[t] = cn[t];
            }
            return;
        }
#pragma unroll
        for (int ai = 0; ai < 2; ++ai)
#pragma unroll
            for (int m = 0; m < 4; ++m) {
                const int row = rowb + ai * 128 + m * 16;
                const float rr = __builtin_amdgcn_rsqf(rrv[ai * 4 + m] * (1.0f / 1024.0f) + EPS);
                if (pn < 16) {
                    const bool isv = pn < 12;
                    bf16* dst = (isv ? V : SGR) + (size_t)row * 1024 + 256 * (isv ? pn - 8 : pn - 12) + 32 * wc + 8 * fq;
#pragma unroll
                    for (int bj = 0; bj < 2; ++bj) { f32x4 v0 = acc[ai][bj][m][0] * rr, v1 = acc[ai][bj][m][1] * rr;
                        if (!isv) {
#pragma unroll
                            for (int j = 0; j < 4; ++j) { v0[j] = silu_f(v0[j]); v1[j] = silu_f(v1[j]); } }
                        pg8::u32x4 w; w.x = pg8::cvt_pk_bf16(v0[0], v0[1]); w.y = pg8::cvt_pk_bf16(v0[2], v0[3]); w.z = pg8::cvt_pk_bf16(v1[0], v1[1]); w.w = pg8::cvt_pk_bf16(v1[2], v1[3]);
                        *(pg8::u32x4*)(dst + 128 * bj) = w; }
                } else if (pn < 24) {
                    bf16* dst = UG + (size_t)row * 1024 + 128 * (pn - 16) + 32 * wc + 8 * fq;
                    f32x4 v0 = acc[ai][0][m][0] * rr, v1 = acc[ai][0][m][1] * rr; const f32x4 g0 = acc[ai][1][m][0] * rr, g1 = acc[ai][1][m][1] * rr;
#pragma unroll
                    for (int j = 0; j < 4; ++j) { v0[j] *= silu_f(g0[j]); v1[j] *= silu_f(g1[j]); }
                    pg8::u32x4 w; w.x = pg8::cvt_pk_bf16(v0[0], v0[1]); w.y = pg8::cvt_pk_bf16(v0[2], v0[3]); w.z = pg8::cvt_pk_bf16(v1[0], v1[1]); w.w = pg8::cvt_pk_bf16(v1[2], v1[3]);
                    *(pg8::u32x4*)dst = w;
                } else {
                    bf16* dst = VG + (size_t)row * 1024 + 256 * (pn - 24) + 32 * wc + 8 * fq;
                    float s1 = 0.f, s2 = 0.f;
#pragma unroll
                    for (int bj = 0; bj < 2; ++bj) { const f32x4 v0 = acc[ai][bj][m][0] * rr, v1 = acc[ai][bj][m][1] * rr;
#pragma unroll
                        for (int j = 0; j < 4; ++j) { s1 += v0[j] + v1[j]; s2 += v0[j] * v0[j] + v1[j] * v1[j]; }
                        pg8::u32x4 w; w.x = pg8::cvt_pk_bf16(v0[0], v0[1]); w.y = pg8::cvt_pk_bf16(v0[2], v0[3]); w.z = pg8::cvt_pk_bf16(v1[0], v1[1]); w.w = pg8::cvt_pk_bf16(v1[2], v1[3]);
                        *(pg8::u32x4*)(dst + 128 * bj) = w; }
                    s1 += __shfl_xor(s1, 16); s1 += __shfl_xor(s1, 32); s2 += __shfl_xor(s2, 16); s2 += __shfl_xor(s2, 32);
                    if (fq == 0) *(f32x2*)(LNS + ((size_t)row * 16 + (pn - 24) * 4 + wc) * 2) = (f32x2){s1, s2};
                }
            }
    }
};
struct EpiRes {
    static constexpr bool PERM = false;
    const float* res_p; float* out; unsigned char* ws; float* RRn;
    __device__ __forceinline__ void operator()(const pg8::f32x4 (&acc)[2][2][4][2], const pg8::Unit& u, int wr, int wc, int fr, int fq) const {
        bf16* const XB = (bf16*)(ws + WS_XB);
        const int rowb = u.pm * 256 + wr * 64 + fr, colb = u.pn * 256 + wc * 32 + 4 * fq;
        f32x4 rc[4], rn[4];
        { const float* rsrc = res_p + (size_t)rowb * 1024 + colb;
#pragma unroll
          for (int q = 0; q < 4; ++q) rc[q] = *(const f32x4*)(rsrc + (q >> 1) * 128 + (q & 1) * 16); }
#pragma unroll
        for (int it = 0; it < 8; ++it) {
            const int ai = it >> 2, m = it & 3, row = rowb + ai * 128 + m * 16;
            if (it < 7) { const float* rsrc = res_p + (size_t)(rowb + ((it + 1) >> 2) * 128 + ((it + 1) & 3) * 16) * 1024 + colb;
#pragma unroll
                for (int q = 0; q < 4; ++q) rn[q] = *(const f32x4*)(rsrc + (q >> 1) * 128 + (q & 1) * 16); }
            float ssq = 0.f;
            float* o = out + (size_t)row * 1024 + colb; bf16* xb = XB + (size_t)row * 1024 + colb;
#pragma unroll
            for (int q = 0; q < 4; ++q) { const int bj = q >> 1, n = q & 1; const f32x4 hn = rc[q] + acc[ai][bj][m][n];
                *(f32x4*)(o + bj * 128 + n * 16) = hn; ssq += (hn.x * hn.x + hn.y * hn.y) + (hn.z * hn.z + hn.w * hn.w);
                pg8::u32x2 w; w.x = pg8::cvt_pk_bf16(hn.x, hn.y); w.y = pg8::cvt_pk_bf16(hn.z, hn.w); *(pg8::u32x2*)(xb + bj * 128 + n * 16) = w; }
            ssq += __shfl_xor(ssq, 16); ssq += __shfl_xor(ssq, 32);
            if (fq == 0) atomicAdd(RRn + row, ssq);
#pragma unroll
            for (int q = 0; q < 4; ++q) rc[q] = rn[q];
        }
    }
};

struct Args { const float* in[11]; float* out; unsigned char* ws; int ph_lo, ph_hi; };

#define CAS __attribute__((address_space(4)))
__device__ __forceinline__ Args fresh_args() { const unsigned long long p0 = (unsigned long long)__builtin_amdgcn_kernarg_segment_ptr();
    unsigned plo = __builtin_amdgcn_readfirstlane((unsigned)p0), phi = __builtin_amdgcn_readfirstlane((unsigned)(p0 >> 32)); asm volatile("" : "+s"(plo), "+s"(phi));
    const CAS Args* q = (const CAS Args*)(((unsigned long long)phi << 32) | plo); Args r;
#pragma unroll
    for (int i = 0; i < 11; ++i) r.in[i] = q->in[i];
    r.out = q->out; r.ws = q->ws; r.ph_lo = q->ph_lo; r.ph_hi = q->ph_hi; return r; }
__device__ __forceinline__ int colmap(int np) {
    const int pn = np >> 8, tc = np & 255;
    if (pn < 8) { const int base = (pn < 4) ? 0 : 1024, head = 2 * (pn & 3) + ((tc & 127) >> 6), part = tc >> 7; return base + 128 * head + 64 * part + (tc & 63); }
    if (pn < 12) return 2048 + 256 * (pn - 8) + tc;
    if (pn < 16) return 3072 + 256 * (pn - 12) + tc;
    if (pn < 24) { const int head = pn - 16; return tc < 128 ? 4096 + 128 * head + tc : 6144 + 128 * head + (tc - 128); }
    return 5120 + 256 * (pn - 24) + tc;
}
__device__ __forceinline__ void p0_transpose_item(const float* W, int K, int N, bf16* WT, const float* gk, int k0, int src_n0, int dst_n0, LAS float* scr, int lane) {
#pragma unroll
    for (int i = 0; i < 32; ++i) { const int kk = 2 * i + (lane >> 5); float v = W[(size_t)(k0 + kk) * N + src_n0 + (lane & 31)]; if (gk) v *= gk[k0 + kk]; scr[kk * 33 + (lane & 31)] = v; }
    LDS_WAIT(); asm volatile("" ::: "memory");
    const int c = lane & 7;
#pragma unroll
    for (int j = 0; j < 4; ++j) { const int n = (lane >> 3) + 8 * j; const LAS float* s = scr + (8 * c) * 33 + n;
        v4u o; o.x = pk2(s[0 * 33], s[1 * 33]); o.y = pk2(s[2 * 33], s[3 * 33]); o.z = pk2(s[4 * 33], s[5 * 33]); o.w = pk2(s[6 * 33], s[7 * 33]);
        *(v4u*)(WT + (size_t)(dst_n0 + n) * K + k0 + 8 * c) = o; }
    LDS_WAIT(); asm volatile("" ::: "memory");
}
__device__ __forceinline__ void p0_prologue(const Args& a, LAS unsigned char* lds, int gw, int NGW, int lane, int wave) {
    LAS float* scr = (LAS float*)(lds + RING_OFF + wave * 16384);
    unsigned char* ws = a.ws;
    constexpr int I1 = (DM / 64) * (NIN / 32), I2 = (MIXW / 64) * (DM / 32), NITEMS = DEPTH * (I1 + I2);
    for (int it = gw; it < NITEMS; it += NGW) {
        const int l = it / (I1 + I2); int r = it % (I1 + I2);
        if (r < I1) { const int kb = r / (NIN / 32), nb = r % (NIN / 32);
            p0_transpose_item(a.in[4] + (size_t)l * DM * NIN, DM, NIN, (bf16*)(ws + WS_WT1) + (size_t)l * NIN * DM, a.in[3] + l * DM, 64 * kb, colmap(32 * nb), 32 * nb, scr, lane); }
        else { r -= I1; const int kb = r / (DM / 32), nb = r % (DM / 32);
            p0_transpose_item(a.in[5] + (size_t)l * MIXW * DM, MIXW, DM, (bf16*)(ws + WS_WT2) + (size_t)l * DM * MIXW, nullptr, 64 * kb, 32 * nb, 32 * nb, scr, lane); }
    }
    for (int m = 2 * gw; m < MT; m += 2 * NGW) {
        f32x4 v[2][4]; float sq[2];
#pragma unroll
        for (int r = 0; r < 2; ++r) { const int mm = m + r; const float* xrow = mm < MP ? a.in[0] + (size_t)mm * DM : a.in[1] + (size_t)(mm - MP) * DM; const f32x4* xr = (const f32x4*)xrow + lane;
#pragma unroll
            for (int j = 0; j < 4; ++j) v[r][j] = xr[64 * j]; }
#pragma unroll
        for (int r = 0; r < 2; ++r) { float s = 0.f;
#pragma unroll
            for (int j = 0; j < 4; ++j) s += (v[r][j].x * v[r][j].x + v[r][j].y * v[r][j].y) + (v[r][j].z * v[r][j].z + v[r][j].w * v[r][j].w);
            sq[r] = wave_sum(s); }
#pragma unroll
        for (int r = 0; r < 2; ++r) { const int mm = m + r;
            unsigned long long* o8 = (unsigned long long*)((bf16*)(ws + WS_XB) + (size_t)mm * DM) + lane;
#pragma unroll
            for (int j = 0; j < 4; ++j) o8[64 * j] = (unsigned long long)pk2(v[r][j].x, v[r][j].y) | ((unsigned long long)pk2(v[r][j].z, v[r][j].w) << 32);
            if (lane < 3) ((float*)(ws + WS_RR))[(size_t)lane * MPAD + mm] = lane == 0 ? sq[r] : 0.f; }
    }
    const int gt = gw * 64 + lane, NGT = NGW * 64;
    for (int i = gt; i < (SEQ + 1) * 64; i += NGT) {
        const int pidx = i >> 6, f = i & 63; const double pos = pidx < SEQ ? (double)pidx : (double)PAST;
        double inv = 1.0; for (int j = 0; j < f; ++j) inv *= 0.8659643233600653;
        const double ang = pos * inv; const double q = __builtin_rint(ang * 0.63661977236758134308);
        double r = __builtin_fma(-q, 1.5707963267948966, ang); r = __builtin_fma(-q, 6.123233995736766e-17, r);
        const double r2 = r * r;
        const double sn = r * (1.0 + r2 * (-1.0 / 6 + r2 * (1.0 / 120 + r2 * (-1.0 / 5040 + r2 * (1.0 / 362880 + r2 * (-1.0 / 39916800 + r2 * (1.0 / 6227020800.0)))))));
        const double cs = 1.0 + r2 * (-0.5 + r2 * (1.0 / 24 + r2 * (-1.0 / 720 + r2 * (1.0 / 40320 + r2 * (-1.0 / 3628800 + r2 * (1.0 / 479001600.0))))));
        const int qi = ((int)q) & 3;
        const double c = qi == 0 ? cs : qi == 1 ? -sn : qi == 2 ? -cs : sn;
        const double s = qi == 0 ? sn : qi == 1 ? cs : qi == 2 ? -sn : -cs;
        ((f32x2*)(ws + WS_ROPE))[i] = (f32x2){(float)c, (float)s};
    }
    for (int i = gt; i < DEPTH * NH * CH * CH; i += NGT) { const int jj = i & 127, ii = (i >> 7) & 127; ((bf16*)(ws + WS_WG))[i] = jj <= ii ? (bf16)f2bf(a.in[6][i]) : (bf16)0; }
}

__device__ __forceinline__ void sample_ret_item(const Args& a, int l, int item, int lane) {
    const int b = item >> 3, h = item & 7; const size_t row = (size_t)MP + b;
    const bf16* Qg = (const bf16*)(a.ws + WS_Q) + row * 1024 + 128 * h; const bf16* Kg = (const bf16*)(a.ws + WS_K) + row * 1024 + 128 * h;
    const bf16* Vg = (const bf16*)(a.ws + WS_V) + row * 1024 + 128 * h; const bf16* Gg = (const bf16*)(a.ws + WS_SGR) + row * 1024 + 128 * h;
    const int c4 = lane & 31, r2 = lane >> 5;
    const float* S0 = a.in[2] + ((((size_t)l * DECB + b) * NH + h) * HD) * HD + (size_t)r2 * HD + 4 * c4;
    float* S1 = a.out + OUT_SS + ((((size_t)l * DECB + b) * NH + h) * HD) * HD + (size_t)r2 * HD + 4 * c4;
    const float gam = exp2f(lg2gamma(h));
    const unsigned qw = *(const unsigned*)(Qg + 2 * lane), kw = *(const unsigned*)(Kg + 2 * lane);
    const v2u vw = *(const v2u*)(Vg + 4 * c4), gw = *(const v2u*)(Gg + 4 * c4);
    const float v0 = bflo(vw.x), v1 = bfhi(vw.x), v2 = bflo(vw.y), v3 = bfhi(vw.y);
    f32x4 o = {0.f, 0.f, 0.f, 0.f};
#pragma unroll
    for (int tb = 0; tb < 4; ++tb) {
        f32x4 sv[16];
#pragma unroll
        for (int u = 0; u < 16; ++u) sv[u] = *(const f32x4*)(S0 + (size_t)(2 * (16 * tb + u)) * HD);
#pragma unroll
        for (int u = 0; u < 16; ++u) { const int t = 16 * tb + u;
            const unsigned qq = __shfl(qw, t), kk = __shfl(kw, t);
            const float qd = r2 ? bfhi(qq) : bflo(qq), kd = r2 ? bfhi(kk) : bflo(kk);
            f32x4 t1; t1.x = sv[u].x + kd * v0; t1.y = sv[u].y + kd * v1; t1.z = sv[u].z + kd * v2; t1.w = sv[u].w + kd * v3;
            o += t1 * qd; *(f32x4*)(S1 + (size_t)(2 * t) * HD) = t1 * gam; }
    }
    o.x += __shfl_xor(o.x, 32); o.y += __shfl_xor(o.y, 32); o.z += __shfl_xor(o.z, 32); o.w += __shfl_xor(o.w, 32);
    float ss = (o.x * o.x + o.y * o.y) + (o.z * o.z + o.w * o.w);
#pragma unroll
    for (int s = 1; s < 32; s <<= 1) ss += __shfl_xor(ss, s);
    const float rs = rsqrtf(ss * (1.0f / 128.0f) + EPS);
    if (r2 == 0) { v2u w; w.x = pk2(o.x * rs * bflo(gw.x), o.y * rs * bfhi(gw.x)); w.y = pk2(o.z * rs * bflo(gw.y), o.w * rs * bfhi(gw.y));
        *(v2u*)((bf16*)(a.ws + WS_CAT) + row * 2048 + 128 * h + 4 * c4) = w; }
}
__device__ __forceinline__ void sample_gm_item(const Args& a, int l, int b, int lane) {
    const size_t row = (size_t)MP + b;
    const f32x4* lp = (const f32x4*)((const float*)(a.ws + WS_LNS) + row * 32); float s1 = 0.f, s2 = 0.f;
#pragma unroll
    for (int i = 0; i < 8; ++i) { const f32x4 p = lp[i]; s1 += p.x + p.z; s2 += p.y + p.w; }
    const float mu = s1 * (1.0f / 1024.0f), var = s2 * (1.0f / 1024.0f) - mu * mu, rstd = rsqrtf(var + EPS);
    const bf16* vg = (const bf16*)(a.ws + WS_VG) + row * 1024; const bf16* ug = (const bf16*)(a.ws + WS_UG) + row * 1024;
    float* gv = a.out + OUT_GV + ((size_t)l * DECB + b) * 1024; bf16* cat = (bf16*)(a.ws + WS_CAT) + row * 2048 + 1024;
    v2u vw[4], uw[4]; f32x4 lg[4], lb[4]; float w00[4], b0[4];
#pragma unroll
    for (int j = 0; j < 4; ++j) { const int c = 4 * lane + 256 * j, h = c >> 7;
        vw[j] = *(const v2u*)(vg + c); uw[j] = *(const v2u*)(ug + c); lg[j] = *(const f32x4*)(a.in[8] + l * 1024 + c); lb[j] = *(const f32x4*)(a.in[9] + l * 1024 + c);
        w00[j] = a.in[6][((size_t)l * NH + h) * CH * CH]; b0[j] = a.in[7][((size_t)l * NH + h) * CH]; }
#pragma unroll
    for (int j = 0; j < 4; ++j) { const int c = 4 * lane + 256 * j;
        f32x4 vn; vn.x = (bflo(vw[j].x) - mu) * rstd * lg[j].x + lb[j].x; vn.y = (bfhi(vw[j].x) - mu) * rstd * lg[j].y + lb[j].y;
        vn.z = (bflo(vw[j].y) - mu) * rstd * lg[j].z + lb[j].z; vn.w = (bfhi(vw[j].y) - mu) * rstd * lg[j].w + lb[j].w;
        *(f32x4*)(gv + c) = vn;
        v2u w; w.x = pk2((w00[j] * vn.x + b0[j]) * bflo(uw[j].x), (w00[j] * vn.y + b0[j]) * bfhi(uw[j].x)); w.y = pk2((w00[j] * vn.z + b0[j]) * bflo(uw[j].y), (w00[j] * vn.w + b0[j]) * bfhi(uw[j].y));
        *(v2u*)(cat + c) = w; }
}
typedef short s16x4 __attribute__((ext_vector_type(4)));
typedef short bf16x8 __attribute__((ext_vector_type(8)));
typedef float f32x16 __attribute__((ext_vector_type(16)));
typedef __bf16 bf16x2v __attribute__((ext_vector_type(2)));
#define MFMA32(a, b, c) __builtin_amdgcn_mfma_f32_32x32x16_bf16((a), (b), (c), 0, 0, 0)
__device__ __forceinline__ unsigned pkbf(float lo, float hi) { const bf16x2v r = __builtin_convertvector((f32x2){lo, hi}, bf16x2v); return __builtin_bit_cast(unsigned, r); }
__device__ __forceinline__ unsigned offb(unsigned row, unsigned ch) { return 256u * row + 16u * (ch ^ (((row & 3u) << 2) | ((row >> 2) & 3u))); }
__device__ __forceinline__ bf16x8 rowfrag(LAS unsigned char* tile, int R0, int lane, int s) { return *(const LAS bf16x8*)(tile + offb(R0 + (lane & 31), 2 * s + (lane >> 5))); }
template <bool PERMK> __device__ __forceinline__ bf16x8 trfrag(LAS unsigned char* tile, int R0, int lane, int c, int ks) {
    const int hh = lane >> 5, blk = (lane >> 4) & 1, q = (lane & 15) >> 2, p = lane & 3;
    const int r0 = R0 + 16 * ks + (PERMK ? 4 * hh : 8 * hh) + q, r1 = r0 + (PERMK ? 8 : 4), ch = 4 * c + 2 * blk + (p >> 1);
    const s16x4 lo = __builtin_amdgcn_ds_read_tr16_b64_v4i16((LAS s16x4*)(tile + offb(r0, ch) + 8 * (p & 1)));
    const s16x4 hi = __builtin_amdgcn_ds_read_tr16_b64_v4i16((LAS s16x4*)(tile + offb(r1, ch) + 8 * (p & 1)));
    return __builtin_shufflevector(lo, hi, 0, 1, 2, 3, 4, 5, 6, 7);
}
__device__ __forceinline__ bf16x8 trfrag64(LAS unsigned char* tile, int lane, int ks) {
    const int hh = lane >> 5, blk = (lane >> 4) & 1, q = (lane & 15) >> 2, p = lane & 3;
    const int r0 = 16 * ks + 8 * hh + q; const int cb = (2 * blk + (p >> 1)) * 16 + 8 * (p & 1);
    const s16x4 lo = __builtin_amdgcn_ds_read_tr16_b64_v4i16((LAS s16x4*)(tile + r0 * 64 + cb));
    const s16x4 hi = __builtin_amdgcn_ds_read_tr16_b64_v4i16((LAS s16x4*)(tile + (r0 + 4) * 64 + cb));
    return __builtin_shufflevector(lo, hi, 0, 1, 2, 3, 4, 5, 6, 7);
}
__device__ __forceinline__ bf16x8 packx(const f32x16& x, int s) {
    v4u p; p.x = pkbf(x[8 * s + 0], x[8 * s + 1]); p.y = pkbf(x[8 * s + 2], x[8 * s + 3]); p.z = pkbf(x[8 * s + 4], x[8 * s + 5]); p.w = pkbf(x[8 * s + 6], x[8 * s + 7]);
    return __builtin_bit_cast(bf16x8, p);
}
__device__ __forceinline__ void stage_tile(LAS unsigned char* tile, const bf16* src, int ld, int tid) {
    v4u w[4];
#pragma unroll
    for (int i = 0; i < 4; ++i) { const int ch = tid + i * NTHR; w[i] = *(const v4u*)(src + (size_t)(ch >> 4) * ld + (ch & 15) * 8); }
#pragma unroll
    for (int i = 0; i < 4; ++i) { const int ch = tid + i * NTHR; *(LAS v4u*)(tile + offb(ch >> 4, ch & 15)) = w[i]; }
}
constexpr int T32K = 32768;

__device__ __forceinline__ void kvscan_wave(const Args& a, int l, int item, int dkb, LAS unsigned char* wl, int lane) {
    const int b = item >> 5, hd = (item >> 2) & 7, dq = item & 3, hh = lane >> 5, cl = lane & 31;
    LAS unsigned char* Kb = wl; LAS unsigned char* Vb = wl + 8192;
    const bf16* Kg = (const bf16*)(a.ws + WS_K) + (size_t)b * SEQ * 1024 + 128 * hd + 32 * dkb + (lane & 3) * 8 + (size_t)(lane >> 2) * 1024;
    const bf16* Vg = (const bf16*)(a.ws + WS_V) + (size_t)b * SEQ * 1024 + 128 * hd + 32 * dq + (lane & 3) * 8 + (size_t)(lane >> 2) * 1024;
    bf16* ST = (bf16*)(a.ws + WS_ST) + ((((size_t)b * NCH) * NH + hd) * HD + 32 * dq + cl) * HD + 32 * dkb + 4 * hh;
    f32x16 S;
#pragma unroll
    for (int i = 0; i < 16; ++i) S[i] = 0.f;
    const float g128 = exp2f(lg2gamma(hd) * 128.0f);
    v4u ka[8], va[8], kb[8], vb[8];
#pragma unroll
    for (int i = 0; i < 8; ++i) { ka[i] = *(const v4u*)(Kg + (size_t)i * 16 * 1024); va[i] = *(const v4u*)(Vg + (size_t)i * 16 * 1024); }
#pragma unroll
    for (int i = 0; i < 8; ++i) { kb[i] = *(const v4u*)(Kg + (size_t)CH * 1024 + (size_t)i * 16 * 1024); vb[i] = *(const v4u*)(Vg + (size_t)CH * 1024 + (size_t)i * 16 * 1024); }
#define KV_STEP(c, kx, vx) do { \
        { bf16* st = ST + (size_t)(c) * NH * HD * HD; \
          _Pragma("unroll") for (int g = 0; g < 4; ++g) { v2u o; o.x = pkbf(S[4 * g], S[4 * g + 1]); o.y = pkbf(S[4 * g + 2], S[4 * g + 3]); *(v2u*)(st + 8 * g) = o; } } \
        _Pragma("unroll") for (int i = 0; i < 8; ++i) { *(LAS v4u*)(Kb + (lane + 64 * i) * 16) = kx[i]; *(LAS v4u*)(Vb + (lane + 64 * i) * 16) = vx[i]; } \
        if ((c) + 2 < NCH) { const size_t o_ = (size_t)((c) + 2) * CH * 1024; \
            _Pragma("unroll") for (int i = 0; i < 8; ++i) { kx[i] = *(const v4u*)(Kg + o_ + (size_t)i * 16 * 1024); vx[i] = *(const v4u*)(Vg + o_ + (size_t)i * 16 * 1024); } } \
        _Pragma("unroll") for (int ks = 0; ks < 8; ++ks) { const bf16x8 A = trfrag64(Kb, lane, ks); const bf16x8 B = trfrag64(Vb, lane, ks); S = MFMA32(A, B, S); } \
        _Pragma("unroll") for (int i = 0; i < 16; ++i) S[i] *= g128; } while (0)
    for (int c = 0; c < NCH; c += 2) { KV_STEP(c, ka, va); KV_STEP(c + 1, kb, vb); }
#undef KV_STEP
    float* so = a.out + OUT_SP + ((((size_t)l * BATCH + b) * NH + hd) * HD) * HD + 32 * dq + cl;
#pragma unroll
    for (int i = 0; i < 16; ++i) so[(size_t)(32 * dkb + (i & 3) + 8 * (i >> 2) + 4 * hh) * HD] = S[i];
}
__device__ __forceinline__ v4u mul_bf16x8(const v4u x, const v4u g) {
    v4u o; o.x = pkbf(bflo(x.x) * bflo(g.x), bfhi(x.x) * bfhi(g.x)); o.y = pkbf(bflo(x.y) * bflo(g.y), bfhi(x.y) * bfhi(g.y));
    o.z = pkbf(bflo(x.z) * bflo(g.z), bfhi(x.z) * bfhi(g.z)); o.w = pkbf(bflo(x.w) * bflo(g.w), bfhi(x.w) * bfhi(g.w)); return o;
}
struct RetRegs { v4u q[4], k[4], v[4], st[4]; };
struct RetGate { v4u g[4]; };
struct GmRegs { v4u vg[4]; f32x2 mur[4]; };
struct GmGate { v4u ug[4]; };
__device__ __forceinline__ void ret_load(RetRegs& R, RetGate& Gt, const Args& a, int item, int tid) {
    const int b = item >> 7, c = (item >> 3) & 15, hd = item & 7; const size_t row0 = (size_t)b * SEQ + c * CH;
    const unsigned go = (unsigned)(((unsigned)row0 + (tid >> 4)) * 1024 + 128 * hd + (tid & 15) * 8) * 2u;
    const unsigned so = (unsigned)((((b * NCH + c) * NH + hd) * HD) * HD + tid * 8) * 2u;
#pragma unroll
    for (int i = 0; i < 4; ++i) { R.q[i] = *(const v4u*)(a.ws + (unsigned)(WS_Q + go + i * 65536u)); R.k[i] = *(const v4u*)(a.ws + (unsigned)(WS_K + go + i * 65536u));
        R.v[i] = *(const v4u*)(a.ws + (unsigned)(WS_V + go + i * 65536u)); R.st[i] = *(const v4u*)(a.ws + (unsigned)(WS_ST + so + i * 8192u));
        Gt.g[i] = *(const v4u*)(a.ws + (unsigned)(WS_SGR + go + i * 65536u)); }
}
__device__ __forceinline__ void ret_store(const RetRegs& R, LAS unsigned char* lds, int tid) {
    const int r = tid >> 4, ch = tid & 15;
#pragma unroll
    for (int i = 0; i < 4; ++i) { const unsigned o = offb(r + 32 * i, ch);
        *(LAS v4u*)(lds + o) = R.q[i]; *(LAS v4u*)(lds + T32K + o) = R.k[i]; *(LAS v4u*)(lds + 2 * T32K + o) = R.v[i]; *(LAS v4u*)(lds + 3 * T32K + o) = R.st[i]; }
}
__device__ __forceinline__ void ret_compute(const Args& a, const RetGate& Gt, int item, LAS unsigned char* lds, int tid) {
    const int b = item >> 7, c = (item >> 3) & 15, hd = item & 7, lane = tid & 63, w = __builtin_amdgcn_readfirstlane(tid >> 6), hh = lane >> 5, cl = lane & 31, ib = w & 3, dh = w >> 2;
    const size_t row0 = (size_t)b * SEQ + c * CH;
    LAS unsigned char* Qt = lds; LAS unsigned char* Kt = lds + T32K; LAS unsigned char* Vt = lds + 2 * T32K; LAS unsigned char* St = lds + 3 * T32K; LAS float* red = (LAS float*)(lds + 4 * T32K);
    bf16x8 qf[8];
#pragma unroll
    for (int s = 0; s < 8; ++s) qf[s] = rowfrag(Qt, 32 * ib, lane, s);
    f32x16 o0, o1;
#pragma unroll
    for (int i = 0; i < 16; ++i) { o0[i] = 0.f; o1[i] = 0.f; }
    for (int jb = 0; jb <= ib; ++jb) {
        f32x16 X;
#pragma unroll
        for (int i = 0; i < 16; ++i) X[i] = 0.f;
#pragma unroll
        for (int s = 0; s < 8; ++s) X = MFMA32(rowfrag(Kt, 32 * jb, lane, s), qf[s], X);
        if (jb == ib) {
#pragma unroll
            for (int i = 0; i < 16; ++i) { const int jl = (i & 3) + 8 * (i >> 2) + 4 * hh; X[i] = jl <= cl ? X[i] : 0.f; }
        }
#pragma unroll
        for (int s2 = 0; s2 < 2; ++s2) { const bf16x8 xb = packx(X, s2);
            o0 = MFMA32(trfrag<true>(Vt, 32 * jb, lane, 2 * dh + 0, s2), xb, o0);
            o1 = MFMA32(trfrag<true>(Vt, 32 * jb, lane, 2 * dh + 1, s2), xb, o1); }
    }
#pragma unroll
    for (int s = 0; s < 8; ++s) { o0 = MFMA32(rowfrag(St, 32 * (2 * dh + 0), lane, s), qf[s], o0); o1 = MFMA32(rowfrag(St, 32 * (2 * dh + 1), lane, s), qf[s], o1); }
    float ssq = 0.f;
#pragma unroll
    for (int i = 0; i < 16; ++i) ssq += o0[i] * o0[i] + o1[i] * o1[i];
    ssq += __shfl_xor(ssq, 32);
    if (lane < 32) red[w * 32 + lane] = ssq;
    __syncthreads();
    const float rs = __builtin_amdgcn_rsqf((red[ib * 32 + cl] + red[(ib + 4) * 32 + cl]) * (1.0f / 128.0f) + EPS);
    { const int tok = 32 * ib + cl;
#pragma unroll
      for (int g = 0; g < 4; ++g) { v2u w0, w1;
          w0.x = pkbf(o0[4 * g] * rs, o0[4 * g + 1] * rs); w0.y = pkbf(o0[4 * g + 2] * rs, o0[4 * g + 3] * rs);
          w1.x = pkbf(o1[4 * g] * rs, o1[4 * g + 1] * rs); w1.y = pkbf(o1[4 * g + 2] * rs, o1[4 * g + 3] * rs);
          *(LAS v2u*)(Qt + offb(tok, 8 * dh + g) + 8 * hh) = w0; *(LAS v2u*)(Qt + offb(tok, 8 * dh + 4 + g) + 8 * hh) = w1; } }
    __syncthreads();
    { const int r = tid >> 4, ch = tid & 15; const unsigned co = (unsigned)(((unsigned)row0 + r) * 2048 + 128 * hd + ch * 8) * 2u;
#pragma unroll
      for (int i = 0; i < 4; ++i) { const v4u x = *(const LAS v4u*)(Qt + offb(r + 32 * i, ch)); *(v4u*)(a.ws + (unsigned)(WS_CAT + co + i * 131072u)) = mul_bf16x8(x, Gt.g[i]); } }
}
__device__ __forceinline__ void gm_load(GmRegs& R, const Args& a, int l, int item, int tid) {
    const int b = item >> 7, c = (item >> 3) & 15, hd = item & 7; const size_t row0 = (size_t)b * SEQ + c * CH; const int r = tid >> 4, c0 = (tid & 15) * 8;
    const unsigned go = (unsigned)(((unsigned)row0 + r) * 1024 + 128 * hd + c0) * 2u, mo = ((unsigned)row0 + r) * 8u;
#pragma unroll
    for (int i = 0; i < 4; ++i) { R.vg[i] = *(const v4u*)(a.ws + (unsigned)(WS_VG + go + i * 65536u)); R.mur[i] = *(const f32x2*)(a.ws + (unsigned)(WS_MUR + mo + i * 256u)); }
}
__device__ __forceinline__ void gm_store(const GmRegs& R, const Args& a, int l, int item, LAS unsigned char* lds, int tid) {
    const int r = tid >> 4, ch = tid & 15, hd = item & 7;
    const float* lg = a.in[8] + l * 1024 + 128 * hd + ch * 8; const float* lb = a.in[9] + l * 1024 + 128 * hd + ch * 8;
    const f32x4 lg0 = *(const f32x4*)lg, lg1 = *(const f32x4*)(lg + 4), lb0 = *(const f32x4*)lb, lb1 = *(const f32x4*)(lb + 4);
#pragma unroll
    for (int i = 0; i < 4; ++i) { const unsigned o = offb(r + 32 * i, ch); const v4u x = R.vg[i]; const float mu = R.mur[i].x, rstd = R.mur[i].y;
        v4u y; y.x = pkbf((bflo(x.x) - mu) * rstd * lg0.x + lb0.x, (bfhi(x.x) - mu) * rstd * lg0.y + lb0.y); y.y = pkbf((bflo(x.y) - mu) * rstd * lg0.z + lb0.z, (bfhi(x.y) - mu) * rstd * lg0.w + lb0.w);
        y.z = pkbf((bflo(x.z) - mu) * rstd * lg1.x + lb1.x, (bfhi(x.z) - mu) * rstd * lg1.y + lb1.y); y.w = pkbf((bflo(x.w) - mu) * rstd * lg1.z + lb1.z, (bfhi(x.w) - mu) * rstd * lg1.w + lb1.w);
        *(LAS v4u*)(lds + o) = y; }
}
__device__ __forceinline__ void gm_gate_load(GmGate& U, const Args& a, int item, int tid) {
    const int b = item >> 7, c = (item >> 3) & 15, hd = item & 7; const unsigned row0 = (unsigned)b * SEQ + c * CH; const unsigned go = (unsigned)((row0 + (tid >> 4)) * 1024 + 128 * hd + (tid & 15) * 8) * 2u;
#pragma unroll
    for (int i = 0; i < 4; ++i) U.ug[i] = *(const v4u*)(a.ws + (unsigned)(WS_UG + go + i * 65536u));
}
__device__ __forceinline__ void gm_compute(const Args& a, const GmGate& Gr, int l, int item, LAS unsigned char* lds, int tid) {
    const int b = item >> 7, c = (item >> 3) & 15, hd = item & 7, lane = tid & 63, w = __builtin_amdgcn_readfirstlane(tid >> 6), hh = lane >> 5, cl = lane & 31, ib = w & 3, gh = w >> 2;
    const size_t row0 = (size_t)b * SEQ + c * CH;
    LAS unsigned char* VNt = lds; LAS unsigned char* Wt = lds + T32K;
    const float bi = a.in[7][((size_t)l * NH + hd) * CH + 32 * ib + cl];
    f32x16 s0, s1;
#pragma unroll
    for (int i = 0; i < 16; ++i) { s0[i] = 0.f; s1[i] = 0.f; }
    for (int ks = 0; ks < 2 * (ib + 1); ++ks) { const bf16x8 B = rowfrag(Wt, 32 * ib, lane, ks);
        s0 = MFMA32(trfrag<false>(VNt, 0, lane, 2 * gh + 0, ks), B, s0); s1 = MFMA32(trfrag<false>(VNt, 0, lane, 2 * gh + 1, ks), B, s1); }
    LAS unsigned char* Ot = lds + 2 * T32K;
    { const int tok = 32 * ib + cl;
#pragma unroll
      for (int g = 0; g < 4; ++g) { v2u w0, w1;
          w0.x = pkbf(s0[4 * g] + bi, s0[4 * g + 1] + bi); w0.y = pkbf(s0[4 * g + 2] + bi, s0[4 * g + 3] + bi);
          w1.x = pkbf(s1[4 * g] + bi, s1[4 * g + 1] + bi); w1.y = pkbf(s1[4 * g + 2] + bi, s1[4 * g + 3] + bi);
          *(LAS v2u*)(Ot + offb(tok, 8 * gh + g) + 8 * hh) = w0; *(LAS v2u*)(Ot + offb(tok, 8 * gh + 4 + g) + 8 * hh) = w1; } }
    __syncthreads();
    { const int r = tid >> 4, ch = tid & 15; const unsigned co = (unsigned)(((unsigned)row0 + r) * 2048 + 1024 + 128 * hd + ch * 8) * 2u;
#pragma unroll
      for (int i = 0; i < 4; ++i) { const v4u x = *(const LAS v4u*)(Ot + offb(r + 32 * i, ch)); *(v4u*)(a.ws + (unsigned)(WS_CAT + co + i * 131072u)) = mul_bf16x8(x, Gr.ug[i]); } }
}
#define OPAQUE_TID(t) int t = tid; asm volatile("" : "+v"(t))
__device__ __forceinline__ void mixer_phase(const Args& a, int l, int bx, int G, LAS unsigned char* lds, int tid) {
    constexpr int NIT = BATCH * NCH * NH;
    RetRegs R; RetGate Gn; GmRegs Gr; GmGate Ug;
    if (bx < NIT) { OPAQUE_TID(t0); ret_load(R, Gn, a, bx, t0); }
    for (int it = bx; it < NIT; it += G) {
        __syncthreads();
        { OPAQUE_TID(t1); ret_store(R, lds, t1); }
        __syncthreads();
        { OPAQUE_TID(t2); gm_load(Gr, a, l, it, t2); }
        { OPAQUE_TID(t3); ret_compute(a, Gn, it, lds, t3); }
        __syncthreads();
        { OPAQUE_TID(t9); gm_gate_load(Ug, a, it, t9); }
        { OPAQUE_TID(t4); gm_store(Gr, a, l, it, lds, t4);
          stage_tile(lds + T32K, (const bf16*)(a.ws + WS_WG) + ((size_t)l * NH + (it & 7)) * CH * CH, 128, t4); }
        __syncthreads();
        if (it + G < NIT) { OPAQUE_TID(t5); ret_load(R, Gn, a, it + G, t5); }
        { OPAQUE_TID(t6); gm_compute(a, Ug, l, it, lds, t6); }
    }
    __syncthreads();
}
__device__ __forceinline__ void mur_rows(const Args& a, int gw, int NGW, int lane) {
    const int r = lane & 7, q = lane >> 3;
    for (int rb = gw * 8; rb < MP; rb += NGW * 8) {
        const f32x4 p = ((const f32x4*)(a.ws + WS_LNS))[(size_t)(rb + r) * 8 + q];
        float s1 = p.x + p.z, s2 = p.y + p.w;
        s1 += __shfl_xor(s1, 8); s2 += __shfl_xor(s2, 8); s1 += __shfl_xor(s1, 16); s2 += __shfl_xor(s2, 16); s1 += __shfl_xor(s1, 32); s2 += __shfl_xor(s2, 32);
        const float mu = s1 * (1.0f / 1024.0f), var = s2 * (1.0f / 1024.0f) - mu * mu;
        if (q == 0) ((f32x2*)(a.ws + WS_MUR))[rb + r] = (f32x2){mu, rsqrtf(var + EPS)};
    }
}

template <int NB, class Epi>
__device__ __forceinline__ void small_gemm_piece(const bf16* X, const bf16* W0, const bf16* W1, int K, LAS unsigned char* lds, int tid, const Epi& E) {
    const int lane = tid & 63, w = __builtin_amdgcn_readfirstlane(tid >> 6), hh = lane >> 5, cl = lane & 31, ib = w & 3, kh = w >> 2;
    const int nsl = K >> 7;
    const int xr_ = tid >> 4, xc_ = tid & 15;
    const bf16* xs = X + (size_t)xr_ * K + xc_ * 8; const bf16* ws0 = W0 + (size_t)xr_ * K + xc_ * 8; const bf16* ws1 = W1 + (size_t)xr_ * K + xc_ * 8;
    f32x16 acc[NB];
#pragma unroll
    for (int nb = 0; nb < NB; ++nb)
#pragma unroll
        for (int i = 0; i < 16; ++i) acc[nb][i] = 0.f;
    v4u xv[4], wv[NB];
#pragma unroll
    for (int i = 0; i < 4; ++i) xv[i] = *(const v4u*)(xs + (size_t)(32 * i) * K);
    wv[0] = *(const v4u*)ws0; if (NB > 1) wv[NB - 1] = *(const v4u*)ws1;
    __syncthreads();
    for (int sl = 0; sl < nsl; ++sl) {
        LAS unsigned char* Xt = lds + (sl & 1) * 49152; LAS unsigned char* Wt = Xt + 32768;
#pragma unroll
        for (int i = 0; i < 4; ++i) *(LAS v4u*)(Xt + offb(xr_ + 32 * i, xc_)) = xv[i];
        *(LAS v4u*)(Wt + offb(xr_, xc_)) = wv[0]; if (NB > 1) *(LAS v4u*)(Wt + offb(xr_ + 32, xc_)) = wv[NB - 1];
        __syncthreads();
        if (sl + 1 < nsl) { const int ko = (sl + 1) * 128;
#pragma unroll
            for (int i = 0; i < 4; ++i) xv[i] = *(const v4u*)(xs + (size_t)(32 * i) * K + ko);
            wv[0] = *(const v4u*)(ws0 + ko); if (NB > 1) wv[NB - 1] = *(const v4u*)(ws1 + ko); }
#pragma unroll
        for (int st = 0; st < 4; ++st) { const int ks = 4 * kh + st; const bf16x8 xf = rowfrag(Xt, 32 * ib, lane, ks);
            acc[0] = MFMA32(rowfrag(Wt, 0, lane, ks), xf, acc[0]);
            if (NB > 1) acc[NB - 1] = MFMA32(rowfrag(Wt, 32, lane, ks), xf, acc[NB - 1]); }
    }
    LAS float* red = (LAS float*)(lds + 98304);
    if (kh == 1) {
#pragma unroll
        for (int nb = 0; nb < NB; ++nb)
#pragma unroll
            for (int i = 0; i < 16; ++i) red[((ib * NB + nb) * 16 + i) * 64 + lane] = acc[nb][i];
    }
    __syncthreads();
    if (kh == 0) {
#pragma unroll
        for (int nb = 0; nb < NB; ++nb)
#pragma unroll
            for (int i = 0; i < 16; ++i) acc[nb][i] += red[((ib * NB + nb) * 16 + i) * 64 + lane];
        E(acc, ib, cl, hh);
    }
    __syncthreads();
}
struct EpiProjS {
    unsigned char* ws; const float* RR; int pn, sl;
    __device__ __forceinline__ void operator()(const f32x16 (&acc)[2], int ib, int cl, int hh) const {
        const int rs_ = 32 * ib + cl; const size_t row = (size_t)MP + rs_;
        const float rr = rsqrtf(RR[row] * (1.0f / 1024.0f) + EPS);
        if (pn < 8) {
            const int head = 2 * (pn & 3) + (sl >> 1), f0 = 32 * (sl & 1) + 4 * hh;
            const float e = lg2gamma(head);
            const float sc = rr * (pn < 4 ? exp2f(e) : exp2f(-e) * 0.08838834764831845f);
            const float* rope = (const float*)(ws + WS_ROPE) + ((size_t)SEQ * 64 + f0) * 2;
            bf16* dst = (bf16*)(ws + (pn < 4 ? WS_Q : WS_K)) + row * 1024 + 128 * head + f0;
#pragma unroll
            for (int g = 0; g < 4; ++g) { const f32x4 c0 = *(const f32x4*)(rope + 16 * g), c1 = *(const f32x4*)(rope + 16 * g + 4);
                const float a0 = acc[0][4 * g], a1 = acc[0][4 * g + 1], a2 = acc[0][4 * g + 2], a3 = acc[0][4 * g + 3];
                const float b0 = acc[1][4 * g], b1 = acc[1][4 * g + 1], b2 = acc[1][4 * g + 2], b3 = acc[1][4 * g + 3];
                v2u o1, o2;
                o1.x = pkbf((a0 * c0.x - b0 * c0.y) * sc, (a1 * c0.z - b1 * c0.w) * sc); o1.y = pkbf((a2 * c1.x - b2 * c1.y) * sc, (a3 * c1.z - b3 * c1.w) * sc);
                o2.x = pkbf((a0 * c0.y + b0 * c0.x) * sc, (a1 * c0.w + b1 * c0.z) * sc); o2.y = pkbf((a2 * c1.y + b2 * c1.x) * sc, (a3 * c1.w + b3 * c1.z) * sc);
                *(v2u*)(dst + 8 * g) = o1; *(v2u*)(dst + 64 + 8 * g) = o2; }
        } else if (pn < 16) {
            const bool isv = pn < 12;
            bf16* dst = (bf16*)(ws + (isv ? WS_V : WS_SGR)) + row * 1024 + 256 * (isv ? pn - 8 : pn - 12) + 32 * sl + 4 * hh;
#pragma unroll
            for (int nb = 0; nb < 2; ++nb)
#pragma unroll
                for (int g = 0; g < 4; ++g) { float v0 = acc[nb][4 * g] * rr, v1 = acc[nb][4 * g + 1] * rr, v2 = acc[nb][4 * g + 2] * rr, v3 = acc[nb][4 * g + 3] * rr;
                    if (!isv) { v0 = silu_f(v0); v1 = silu_f(v1); v2 = silu_f(v2); v3 = silu_f(v3); }
                    v2u o; o.x = pkbf(v0, v1); o.y = pkbf(v2, v3); *(v2u*)(dst + 128 * nb + 8 * g) = o; }
        } else if (pn < 24) {
            bf16* dst = (bf16*)(ws + WS_UG) + row * 1024 + 128 * (pn - 16) + 32 * sl + 4 * hh;
#pragma unroll
            for (int g = 0; g < 4; ++g) { v2u o;
                o.x = pkbf(acc[0][4 * g] * rr * silu_f(acc[1][4 * g] * rr), acc[0][4 * g + 1] * rr * silu_f(acc[1][4 * g + 1] * rr));
                o.y = pkbf(acc[0][4 * g + 2] * rr * silu_f(acc[1][4 * g + 2] * rr), acc[0][4 * g + 3] * rr * silu_f(acc[1][4 * g + 3] * rr));
                *(v2u*)(dst + 8 * g) = o; }
        } else {
            bf16* dst = (bf16*)(ws + WS_VG) + row * 1024 + 256 * (pn - 24) + 32 * sl + 4 * hh;
            float s1 = 0.f, s2 = 0.f;
#pragma unroll
            for (int nb = 0; nb < 2; ++nb)
#pragma unroll
                for (int g = 0; g < 4; ++g) { const float v0 = acc[nb][4 * g] * rr, v1 = acc[nb][4 * g + 1] * rr, v2 = acc[nb][4 * g + 2] * rr, v3 = acc[nb][4 * g + 3] * rr;
                    s1 += (v0 + v1) + (v2 + v3); s2 += (v0 * v0 + v1 * v1) + (v2 * v2 + v3 * v3);
                    v2u o; o.x = pkbf(v0, v1); o.y = pkbf(v2, v3); *(v2u*)(dst + 128 * nb + 8 * g) = o; }
            s1 += __shfl_xor(s1, 32); s2 += __shfl_xor(s2, 32);
            if (hh == 0) *(f32x2*)((float*)(ws + WS_LNS) + (row * 16 + (pn - 24) * 4 + sl) * 2) = (f32x2){s1, s2};
        }
    }
};
struct EpiResS {
    const float* res; float* out; unsigned char* ws; float* RRn; int nbk;
    __device__ __forceinline__ void operator()(const f32x16 (&acc)[1], int ib, int cl, int hh) const {
        const int rs_ = 32 * ib + cl; const size_t o = (size_t)rs_ * 1024 + 32 * nbk + 4 * hh;
        bf16* xb = (bf16*)(ws + WS_XB) + (size_t)MP * 1024 + o; float ssq = 0.f;
        f32x4 r[4];
#pragma unroll
        for (int g = 0; g < 4; ++g) r[g] = *(const f32x4*)(res + o + 8 * g);
#pragma unroll
        for (int g = 0; g < 4; ++g) { f32x4 hn; hn.x = r[g].x + acc[0][4 * g]; hn.y = r[g].y + acc[0][4 * g + 1]; hn.z = r[g].z + acc[0][4 * g + 2]; hn.w = r[g].w + acc[0][4 * g + 3];
            *(f32x4*)(out + o + 8 * g) = hn; ssq += (hn.x * hn.x + hn.y * hn.y) + (hn.z * hn.z + hn.w * hn.w);
            v2u wv; wv.x = pkbf(hn.x, hn.y); wv.y = pkbf(hn.z, hn.w); *(v2u*)(xb + 8 * g) = wv; }
        ssq += __shfl_xor(ssq, 32);
        if (hh == 0) atomicAdd(RRn + MP + rs_, ssq);
    }
};

constexpr int NPHASE = 10;
__global__ void __launch_bounds__(NTHR, 2) fwd_kernel(Args args) {
    extern __shared__ __attribute__((aligned(16))) unsigned char lds_raw[];
    LAS unsigned char* lds = (LAS unsigned char*)lds_raw;
    volatile LAS unsigned* MISC = (volatile LAS unsigned*)(lds + MISC_OFF);
    const int G = gridDim.x, bx = blockIdx.x, NGW = G * NWAVES;
    if (threadIdx.x < 128) MISC[threadIdx.x] = 0u;
#define PHASE_IDS() int tid = threadIdx.x; asm volatile("" : "+v"(tid)); const int lane = tid & 63, wave = __builtin_amdgcn_readfirstlane(tid >> 6), gw = bx * NWAVES + wave; (void)lane; (void)gw
    __syncthreads();
#if MK_PER_PHASE
#define GRID_BAR() do { } while (0)
#else
    XcdBarrier bar = xcd_barrier_post((unsigned*)(args.ws + WS_CTL) + 1024, MISC + 8);
#define GRID_BAR() xcd_barrier(bar)
#endif
    const int lo = args.ph_lo, hi = args.ph_hi;
#define IN(k) (lo <= (k) && (k) < hi)
#define SEAM(k) do { if (IN(k) && IN((k) + 1)) GRID_BAR(); } while (0)
#ifndef REPEAT_MASK
#define REPEAT_MASK 0
#endif
#define NREP(k) (((REPEAT_MASK >> (k)) & 1) ? 2 : 1)

    if (IN(0)) for (int rep = 0; rep < NREP(0); ++rep) { if (rep) GRID_BAR(); PHASE_IDS(); const Args a = fresh_args(); p0_prologue(a, lds, gw, NGW, lane, wave); }
    SEAM(0);
    for (int l = 0; l < DEPTH; ++l) {
        const int p = 1 + 4 * l;
        if (IN(p)) for (int rep = 0; rep < NREP(p); ++rep) {
            if (rep) GRID_BAR();
            const Args a = fresh_args();
            { PHASE_IDS();
              for (int pc = bx; pc < 28 * 4; pc += G) { const int pn = pc >> 2, sl = pc & 3;
                  const bf16* Wt = (const bf16*)(a.ws + WS_WT1) + (size_t)l * NIN * DM + (size_t)(256 * pn + 32 * sl) * DM;
                  EpiProjS ES{a.ws, (const float*)(a.ws + WS_RR) + (size_t)l * MPAD, pn, sl};
                  small_gemm_piece<2, EpiProjS>((const bf16*)(a.ws + WS_XB) + (size_t)MP * DM, Wt, Wt + (size_t)128 * DM, DM, lds, tid, ES); } }
            pg8::Gemm g{(const bf16*)(a.ws + WS_XB), (const bf16*)(a.ws + WS_WT1) + (size_t)l * NIN * DM, MP, NIN, DM};
            pg8::StaticOrder S; S.init(MP, NIN, G, bx);
            EpiProj E{a.ws, (const float*)(a.ws + WS_RR) + (size_t)l * MPAD};
            pg8::gemm_phase<EpiProj, pg8::StaticOrder, true, true>(lds + RING_OFF, g, S, E);
        }
        SEAM(p);
        if (IN(p + 1)) for (int rep = 0; rep < NREP(p + 1); ++rep) {
            if (rep) GRID_BAR();
            PHASE_IDS(); const Args a = fresh_args();
            if (wave < 4) { for (int it = bx; it < BATCH * NH * 4; it += G) kvscan_wave(a, l, it, wave, lds + wave * 16384, lane); }
            else { for (int it = bx * 4 + wave - 4; it < DECB * NH; it += 4 * G) sample_ret_item(a, l, it, lane);
                   for (int it = bx * 4 + wave - 4; it < DECB; it += 4 * G) sample_gm_item(a, l, it, lane); }
            mur_rows(a, gw, NGW, lane);
        }
        SEAM(p + 1);
        if (IN(p + 2)) for (int rep = 0; rep < NREP(p + 2); ++rep) {
            if (rep) GRID_BAR();
            PHASE_IDS(); const Args a = fresh_args();
            mixer_phase(a, l, bx, G, lds, tid);
        }
        SEAM(p + 2);
        if (IN(p + 3)) for (int rep = 0; rep < NREP(p + 3); ++rep) {
            if (rep) GRID_BAR();
            const Args a = fresh_args();
            { PHASE_IDS();
              for (int pc = bx; pc < 32; pc += G) {
                  const bf16* Wt = (const bf16*)(a.ws + WS_WT2) + (size_t)l * DM * MIXW + (size_t)(32 * pc) * MIXW;
                  EpiResS ES{l == 0 ? a.in[1] : (const float*)(a.ws + WS_H32) + (size_t)MP * DM, l == 0 ? (float*)(a.ws + WS_H32) + (size_t)MP * DM : a.out + OUT_Y + (size_t)MP * DM, a.ws, (float*)(a.ws + WS_RR) + (size_t)(l + 1) * MPAD, pc};
                  small_gemm_piece<1, EpiResS>((const bf16*)(a.ws + WS_CAT) + (size_t)MP * MIXW, Wt, Wt, MIXW, lds, tid, ES); } }
            pg8::Gemm g{(const bf16*)(a.ws + WS_CAT), (const bf16*)(a.ws + WS_WT2) + (size_t)l * DM * MIXW, MP, DM, MIXW};
            pg8::StaticOrder S; S.init(MP, DM, G, bx);
            EpiRes E{l == 0 ? a.in[0] : (const float*)(a.ws + WS_H32), l == 0 ? (float*)(a.ws + WS_H32) : a.out + OUT_Y, a.ws, (float*)(a.ws + WS_RR) + (size_t)(l + 1) * MPAD};
            pg8::gemm_phase<EpiRes, pg8::StaticOrder, true, true>(lds + RING_OFF, g, S, E);
        }
        SEAM(p + 3);
    }
    if (IN(9)) {
        PHASE_IDS(); const Args a = fresh_args();
        const f32x4* fg = (const f32x4*)a.in[10] + lane; f32x4 fgv[4];
#pragma unroll
        for (int j = 0; j < 4; ++j) fgv[j] = fg[64 * j];
        const float* RR2 = (const float*)(a.ws + WS_RR) + (size_t)2 * MPAD;
        for (int m = 2 * gw; m < MT; m += 2 * NGW) {
            f32x4 v[2][4]; float ss[2];
#pragma unroll
            for (int r = 0; r < 2; ++r) { ss[r] = RR2[m + r]; const f32x4* yr = (const f32x4*)(a.out + OUT_Y + (size_t)(m + r) * DM) + lane;
#pragma unroll
                for (int j = 0; j < 4; ++j) v[r][j] = yr[64 * j]; }
#pragma unroll
            for (int r = 0; r < 2; ++r) { const float rr = rsqrtf(ss[r] * (1.0f / 1024.0f) + EPS); f32x4* yr = (f32x4*)(a.out + OUT_Y + (size_t)(m + r) * DM) + lane;
#pragma unroll
                for (int j = 0; j < 4; ++j) yr[64 * j] = v[r][j] * rr * fgv[j]; }
        }
    }
#undef IN
#undef SEAM
}

extern "C" void kernel_launch(void* const* d_in, const int* in_sizes, int n_in, void* d_out, int out_size, void* d_ws, size_t ws_size, hipStream_t stream) {
    static int grid = 0;
    if (grid == 0) {
        int dev = 0, cus = 0;
        if (n_in != 11 || ws_size < WS_END) { fprintf(stderr, "kernel_launch: unexpected n_in %d / ws_size %zu\n", n_in, ws_size); grid = -1; return; }
        if (hipGetDevice(&dev) != hipSuccess || hipDeviceGetAttribute(&cus, hipDeviceAttributeMultiprocessorCount, dev) != hipSuccess) { grid = -1; return; }
        if (hipFuncSetAttribute((const void*)fwd_kernel, hipFuncAttributeMaxDynamicSharedMemorySize, LDS_BYTES) != hipSuccess) { grid = -1; return; }
        (void)hipGetLastError();
        grid = cus;
    }
    if (grid < 0) return;
    (void)hipMemsetAsync((char*)d_ws + WS_CTL, 0, CTL_ZERO_BYTES, stream);
    Args a{};
    for (int i = 0; i < 11; ++i) a.in[i] = (const float*)d_in[i];
    a.out = (float*)d_out; a.ws = (unsigned char*)d_ws;
#if MK_PER_PHASE
    for (int p = 0; p < NPHASE; ++p) { a.ph_lo = p; a.ph_hi = p + 1; hipLaunchKernelGGL(fwd_kernel, dim3(grid), dim3(NTHR), LDS_BYTES, stream, a); }
#else
    a.ph_lo = 0; a.ph_hi = NPHASE; hipLaunchKernelGGL(fwd_kernel, dim3(grid), dim3(NTHR), LDS_BYTES, stream, a);
#endif
}
```
